# Optimizing an MI355X kernel written in HIP

```python
import math
import jax, jax.numpy as jnp
from jax import lax
import numpy as np

D_MODEL = 1024
BATCH = 8
SEQ = 2048
DEPTH = 1
DEC_BATCH = 8
DEC_SEQ = 64
PAST_LEN = 1024

CHUNK = 64
WINDOW = 128
WIN_CHUNKS = WINDOW // CHUNK
N_HEADS = 8
N_KV_HEADS = 2
HEAD_DIM = 64
Q_PER_KV = N_HEADS // N_KV_HEADS
ATTN_WIDTH = N_HEADS * HEAD_DIM
KV_WIDTH = N_KV_HEADS * HEAD_DIM
ROT_DIM = HEAD_DIM // 4
ROPE_THETA = 500000.0
SSM_WIDTH = D_MODEL // 2
SSM_GROUP = 16
SSM_GROUPS = SSM_WIDTH // SSM_GROUP
SSM_STATE = 64
PLE_DIM = 256
N_BRANCH = 2
IN_WIDTH = 2 * ATTN_WIDTH + 2 * KV_WIDTH + 2 * SSM_WIDTH + N_BRANCH * D_MODEL
EPS = 1e-6

kernel_name = "hybrid_swa_sink_s5_streaming_step"


def rmsnorm(x, gain):
    xf = x.astype(jnp.float32)
    y = xf * lax.rsqrt(jnp.mean(xf * xf, axis=-1, keepdims=True) + EPS) * gain.astype(jnp.float32)
    return y.astype(x.dtype)


def rope_partial(x, pos):
    half = ROT_DIM // 2
    inv = jnp.power(ROPE_THETA, -jnp.arange(half, dtype=jnp.float32) * 2.0 / ROT_DIM)
    ang = pos.astype(jnp.float32)[:, None] * inv[None, :]
    cos = jnp.cos(ang)[None, :, None, :]
    sin = jnp.sin(ang)[None, :, None, :]
    xf = x.astype(jnp.float32)
    x1, x2, rest = xf[..., :half], xf[..., half:ROT_DIM], xf[..., ROT_DIM:]
    out = jnp.concatenate([x1 * cos - x2 * sin, x2 * cos + x1 * sin, rest], axis=-1)
    return out.astype(x.dtype)


def sink_attention(q, k, v, valid, sinks):
    f32 = jnp.float32
    s = jnp.einsum('bnqhgd,bnkhd->bnhgqk', q.astype(f32), k.astype(f32)) * (HEAD_DIM ** -0.5)
    if valid is not None:
        s = jnp.where(valid[None, :, None, None, None, :], s, -jnp.inf)
    sink = sinks.astype(f32).reshape(N_KV_HEADS, Q_PER_KV)[None, None, :, :, None, None]
    m = jnp.maximum(jnp.max(s, axis=-1, keepdims=True), sink)
    e = jnp.exp(s - m)
    w = e / (jnp.sum(e, axis=-1, keepdims=True) + jnp.exp(sink - m))
    o = jnp.einsum('bnhgqk,bnkhd->bnqhgd', w, v.astype(f32))
    return o.astype(q.dtype)


def prompt_attention(q, k, v, sinks):
    b, t = q.shape[0], q.shape[1]
    nc = t // CHUNK
    pad = WIN_CHUNKS * CHUNK
    qc = q.reshape(b, nc, CHUNK, N_KV_HEADS, Q_PER_KV, HEAD_DIM)

    def band(x):
        xp = jnp.pad(x, ((0, 0), (pad, 0), (0, 0), (0, 0)))
        xc = xp.reshape(b, nc + WIN_CHUNKS, CHUNK, N_KV_HEADS, HEAD_DIM)
        return jnp.concatenate([xc[:, j:j + nc] for j in range(WIN_CHUNKS + 1)], axis=2)

    key_pos = (jnp.arange(nc)[:, None] - WIN_CHUNKS) * CHUNK + jnp.arange((WIN_CHUNKS + 1) * CHUNK)[None, :]
    o = sink_attention(qc, band(k), band(v), key_pos >= 0, sinks)
    return o.reshape(b, t, ATTN_WIDTH), k[:, -WINDOW:], v[:, -WINDOW:]


def sample_attention(q, k, v, cache_k, cache_v, sinks):
    b, s = q.shape[0], q.shape[1]
    kk = jnp.concatenate([cache_k.astype(k.dtype), k], axis=1)
    vv = jnp.concatenate([cache_v.astype(v.dtype), v], axis=1)
    qs = q.reshape(b, 1, s, N_KV_HEADS, Q_PER_KV, HEAD_DIM)
    o = sink_attention(qs, kk[:, None], vv[:, None], None, sinks)
    return o.reshape(b, s, ATTN_WIDTH), kk[:, -WINDOW:], vv[:, -WINDOW:]


def ssm_branch(u, h0_re, h0_im, a_re, a_im, log_dt, b_re, b_im, c_re, c_im, d_skip, w_glu):
    f32 = jnp.float32
    bsz, t, _ = u.shape
    lam = lax.complex(a_re.astype(f32), a_im.astype(f32))
    dt = jnp.exp(log_dt.astype(f32))[:, None]
    a_bar = jnp.exp(lam * dt)
    bmat = lax.complex(b_re.astype(f32), b_im.astype(f32))
    b_bar = ((a_bar - 1.0) / lam)[..., None] * bmat
    cmat = lax.complex(c_re.astype(f32), c_im.astype(f32))
    uf = u.astype(f32)
    ug = uf.reshape(bsz, t, SSM_GROUPS, SSM_GROUP).astype(jnp.complex64)
    bu = jnp.einsum('gpc,btgc->btgp', b_bar, ug)
    if h0_re is not None:
        h0 = lax.complex(h0_re.astype(f32), h0_im.astype(f32))
        bu = bu.at[:, 0].add(a_bar[None] * h0)
    a_seq = jnp.broadcast_to(a_bar, bu.shape)

    def combine(left, right):
        a1, b1 = left
        a2, b2 = right
        return a1 * a2, a2 * b1 + b2

    _, h = lax.associative_scan(combine, (a_seq, bu), axis=1)
    y = jnp.einsum('gcp,btgp->btgc', cmat, h).real.reshape(bsz, t, SSM_WIDTH)
    y = y + d_skip.astype(f32) * uf
    z = jax.nn.gelu(y)
    z = z * jax.nn.sigmoid(z @ w_glu.astype(f32))
    h_last = h[:, -1]
    return z.astype(u.dtype), h_last.real, h_last.imag


def trunk_layer(h, p, pos, attend, h0_re, h0_im, norm_gain, w_in, w_o_attn,
                ssm_a_re, ssm_a_im, ssm_log_dt, ssm_b_re, ssm_b_im, ssm_c_re, ssm_c_im,
                ssm_d, ssm_w_glu, w_o_ssm, w_out, w_ple_gate, w_ple_proj):
    b, t, _ = h.shape
    xn = rmsnorm(h, norm_gain)
    z = xn @ w_in
    o0 = ATTN_WIDTH
    o1 = o0 + KV_WIDTH
    o2 = o1 + KV_WIDTH
    o3 = o2 + ATTN_WIDTH
    o4 = o3 + SSM_WIDTH
    o5 = o4 + SSM_WIDTH
    o6 = o5 + D_MODEL
    q = rope_partial(z[..., :o0].reshape(b, t, N_HEADS, HEAD_DIM), pos)
    k = rope_partial(z[..., o0:o1].reshape(b, t, N_KV_HEADS, HEAD_DIM), pos)
    v = z[..., o1:o2].reshape(b, t, N_KV_HEADS, HEAD_DIM)
    z_attn = z[..., o2:o3]
    u = z[..., o3:o4]
    z_ssm = z[..., o4:o5]
    g_attn = z[..., o5:o6]
    g_ssm = z[..., o6:]

    attn, k_state, v_state = attend(q, k, v)
    ssm, s_re, s_im = ssm_branch(u, h0_re, h0_im, ssm_a_re, ssm_a_im, ssm_log_dt, ssm_b_re,
                                 ssm_b_im, ssm_c_re, ssm_c_im, ssm_d, ssm_w_glu)
    ya = (attn * jax.nn.silu(z_attn)) @ w_o_attn
    ys = (ssm * jax.nn.silu(z_ssm)) @ w_o_ssm
    merged = jax.nn.sigmoid(g_attn) * ya + jax.nn.sigmoid(g_ssm) * ys
    h = h + merged @ w_out
    h = h + jax.nn.sigmoid(h @ w_ple_gate) * (p @ w_ple_proj)
    return h, k_state, v_state, s_re, s_im


def setup_inputs(seed: int = 0) -> dict:
    key = jax.random.key(seed)
    ks = jax.random.split(key, 32)
    nrm = jax.random.normal
    f32 = jnp.float32
    d = {}
    d["x_prompt"] = nrm(ks[0], (BATCH, SEQ, D_MODEL), f32)
    d["x_sample"] = nrm(ks[1], (DEC_BATCH, DEC_SEQ, D_MODEL), f32)
    d["p_prompt"] = nrm(ks[2], (DEPTH, BATCH, SEQ, PLE_DIM), f32)
    d["p_sample"] = nrm(ks[3], (DEPTH, DEC_BATCH, DEC_SEQ, PLE_DIM), f32)
    d["cache_attn_k"] = nrm(ks[4], (DEPTH, DEC_BATCH, WINDOW, N_KV_HEADS, HEAD_DIM), f32)
    d["cache_attn_v"] = nrm(ks[5], (DEPTH, DEC_BATCH, WINDOW, N_KV_HEADS, HEAD_DIM), f32)
    d["state_ssm_re"] = 0.1 * nrm(ks[6], (DEPTH, DEC_BATCH, SSM_GROUPS, SSM_STATE), f32)
    d["state_ssm_im"] = 0.1 * nrm(ks[7], (DEPTH, DEC_BATCH, SSM_GROUPS, SSM_STATE), f32)
    d["norm_gain"] = 1.0 + 0.02 * nrm(ks[8], (DEPTH, D_MODEL), f32)
    d["w_in"] = nrm(ks[9], (DEPTH, D_MODEL, IN_WIDTH), f32) * D_MODEL ** -0.5
    d["attn_sinks"] = 0.5 * nrm(ks[10], (DEPTH, N_HEADS), f32)
    d["w_o_attn"] = nrm(ks[11], (DEPTH, ATTN_WIDTH, D_MODEL), f32) * ATTN_WIDTH ** -0.5
    d["ssm_a_re"] = -0.5 + 0.01 * nrm(ks[12], (DEPTH, SSM_GROUPS, SSM_STATE), f32)
    d["ssm_a_im"] = (math.pi * jnp.arange(SSM_STATE, dtype=f32))[None, None, :] + 0.01 * nrm(ks[13], (DEPTH, SSM_GROUPS, SSM_STATE), f32)
    d["ssm_log_dt"] = jax.random.uniform(ks[14], (DEPTH, SSM_GROUPS), f32, math.log(1e-3), math.log(1e-1))
    d["ssm_b_re"] = nrm(ks[15], (DEPTH, SSM_GROUPS, SSM_STATE, SSM_GROUP), f32) * (2 * SSM_GROUP) ** -0.5
    d["ssm_b_im"] = nrm(ks[16], (DEPTH, SSM_GROUPS, SSM_STATE, SSM_GROUP), f32) * (2 * SSM_GROUP) ** -0.5
    d["ssm_c_re"] = nrm(ks[17], (DEPTH, SSM_GROUPS, SSM_GROUP, SSM_STATE), f32) * SSM_STATE ** -0.5
    d["ssm_c_im"] = nrm(ks[18], (DEPTH, SSM_GROUPS, SSM_GROUP, SSM_STATE), f32) * SSM_STATE ** -0.5
    d["ssm_d"] = nrm(ks[19], (DEPTH, SSM_WIDTH), f32)
    d["ssm_w_glu"] = nrm(ks[20], (DEPTH, SSM_WIDTH, SSM_WIDTH), f32) * SSM_WIDTH ** -0.5
    d["w_o_ssm"] = nrm(ks[21], (DEPTH, SSM_WIDTH, D_MODEL), f32) * SSM_WIDTH ** -0.5
    d["w_out"] = nrm(ks[22], (DEPTH, D_MODEL, D_MODEL), f32) * D_MODEL ** -0.5
    d["w_ple_gate"] = nrm(ks[23], (DEPTH, D_MODEL, D_MODEL), f32) * D_MODEL ** -0.5
    d["w_ple_proj"] = nrm(ks[24], (DEPTH, PLE_DIM, D_MODEL), f32) * PLE_DIM ** -0.5
    d["final_norm_gain"] = 1.0 + 0.02 * nrm(ks[25], (D_MODEL,), f32)
    return d


def reference(x_prompt, x_sample, p_prompt, p_sample, cache_attn_k, cache_attn_v,
              state_ssm_re, state_ssm_im, norm_gain, w_in, attn_sinks, w_o_attn,
              ssm_a_re, ssm_a_im, ssm_log_dt, ssm_b_re, ssm_b_im, ssm_c_re, ssm_c_im,
              ssm_d, ssm_w_glu, w_o_ssm, w_out, w_ple_gate, w_ple_proj, final_norm_gain):
    pos_p = jnp.arange(x_prompt.shape[1])
    pos_s = PAST_LEN + jnp.arange(x_sample.shape[1])
    h_p, h_s = x_prompt, x_sample
    kp_l, vp_l, rp_l, ip_l, ks_l, vs_l, rs_l, is_l = [], [], [], [], [], [], [], []
    for i in range(DEPTH):
        lw = (norm_gain[i], w_in[i], w_o_attn[i], ssm_a_re[i], ssm_a_im[i], ssm_log_dt[i],
              ssm_b_re[i], ssm_b_im[i], ssm_c_re[i], ssm_c_im[i], ssm_d[i], ssm_w_glu[i],
              w_o_ssm[i], w_out[i], w_ple_gate[i], w_ple_proj[i])
        sinks = attn_sinks[i]
        ck, cv = cache_attn_k[i], cache_attn_v[i]
        h_p, kp, vp, rp, ip = trunk_layer(
            h_p, p_prompt[i], pos_p,
            lambda q, k, v: prompt_attention(q, k, v, sinks),
            None, None, *lw)
        h_s, ks_, vs_, rs_, is_ = trunk_layer(
            h_s, p_sample[i], pos_s,
            lambda q, k, v: sample_attention(q, k, v, ck, cv, sinks),
            state_ssm_re[i], state_ssm_im[i], *lw)
        kp_l.append(kp); vp_l.append(vp); rp_l.append(rp); ip_l.append(ip)
        ks_l.append(ks_); vs_l.append(vs_); rs_l.append(rs_); is_l.append(is_)
    y_prompt = rmsnorm(h_p, final_norm_gain)
    y_sample = rmsnorm(h_s, final_norm_gain)
    new_k_prompt = jnp.stack(kp_l)
    new_v_prompt = jnp.stack(vp_l)
    new_ssm_re_prompt = jnp.stack(rp_l)
    new_ssm_im_prompt = jnp.stack(ip_l)
    new_k_sample = jnp.stack(ks_l)
    new_v_sample = jnp.stack(vs_l)
    new_ssm_re_sample = jnp.stack(rs_l)
    new_ssm_im_sample = jnp.stack(is_l)
    return (y_prompt, y_sample, new_k_prompt, new_v_prompt, new_ssm_re_prompt, new_ssm_im_prompt,
            new_k_sample, new_v_sample, new_ssm_re_sample, new_ssm_im_sample)
```

```cpp
#include <hip/hip_runtime.h>
#include <cstdio>
#include <cstdint>

typedef float f32x2_t __attribute__((ext_vector_type(2)));
typedef __bf16 bf16x2_t __attribute__((ext_vector_type(2)));
__device__ __forceinline__ unsigned cvtpk_s(float lo, float hi) { f32x2_t v = {lo, hi}; bf16x2_t b = __builtin_convertvector(v, bf16x2_t); return __builtin_bit_cast(unsigned, b); }
__device__ __forceinline__ float bf_lo(unsigned w) { return __uint_as_float(w << 16); }
__device__ __forceinline__ float bf_hi(unsigned w) { return __uint_as_float(w & 0xffff0000u); }
__device__ __forceinline__ float fast_exp(float x) { return __builtin_amdgcn_exp2f(x * 1.4426950408889634f); }
__device__ __forceinline__ float sigmoid_f(float x) { return __builtin_amdgcn_rcpf(1.0f + fast_exp(-x)); }
__device__ __forceinline__ float silu_f(float x) { return x * sigmoid_f(x); }
__device__ __forceinline__ float gelu_tanh_f(float x) { const float u = 1.5957691216057308f * (x + 0.044715f * x * x * x); return x * sigmoid_f(u); }

constexpr int DM = 1024, SEQ = 2048, NB = 8, DSEQ = 64, MP = NB * SEQ  , MS = NB * DSEQ  , M = MP + MS  ;
constexpr int INW = 4352, PLE = 256, PAST = 1024;
constexpr float EPS = 1e-6f;
constexpr size_t OFF_Y = 0, OFF_KP = (size_t)M * DM, OFF_VP = OFF_KP + 131072, OFF_SRP = OFF_VP + 131072, OFF_SIP = OFF_SRP + 16384,
                 OFF_KS = OFF_SIP + 16384, OFF_VS = OFF_KS + 131072, OFF_SRS = OFF_VS + 131072, OFF_SIS = OFF_SRS + 16384, OUT_TOTAL = OFF_SIS + 16384;

constexpr size_t MiB = 1u << 20;
constexpr size_t WS_CTL = 0, CTL_ZERO_BYTES = 1 * MiB;
constexpr size_t WS_WIN = 2 * MiB;
constexpr size_t WS_WST = 11 * MiB;
constexpr size_t WS_WGLU = 13 * MiB;
constexpr size_t WS_WOUT = 14 * MiB;
constexpr size_t WS_WPG = 16 * MiB;
constexpr size_t WS_WPP = 18 * MiB;
constexpr size_t WS_ROPE = 19 * MiB;
constexpr size_t WS_SSMB = 19 * MiB + 256 * 1024;
constexpr size_t WS_SSMC = 19 * MiB + 512 * 1024;
constexpr size_t WS_APOW = 19 * MiB + 768 * 1024;
constexpr size_t WS_SLOC = 20 * MiB;
constexpr size_t WS_SSQ = 24 * MiB;
constexpr size_t WS_XN = 32 * MiB;
constexpr size_t WS_P = 66 * MiB;
constexpr size_t WS_Q = 75 * MiB;
constexpr size_t WS_K = 92 * MiB;
constexpr size_t WS_V = 97 * MiB;
constexpr size_t WS_ZA = 102 * MiB;
constexpr size_t WS_U = 119 * MiB;
constexpr size_t WS_ZS = 136 * MiB;
constexpr size_t WS_GA = 153 * MiB;
constexpr size_t WS_GS = 186 * MiB;
constexpr size_t WS_AST = 219 * MiB;
constexpr size_t WS_END = 252 * MiB;
static_assert(WS_XN + (size_t)M * 1024 * 2 <= WS_P && WS_P + (size_t)M * 256 * 2 <= WS_Q && WS_Q + (size_t)M * 512 * 2 <= WS_K && WS_K + (size_t)M * 128 * 2 <= WS_V && WS_V + (size_t)M * 128 * 2 <= WS_ZA &&
              WS_ZA + (size_t)M * 512 * 2 <= WS_U && WS_U + (size_t)M * 512 * 2 <= WS_ZS && WS_ZS + (size_t)M * 512 * 2 <= WS_GA && WS_GA + (size_t)M * 1024 * 2 <= WS_GS && WS_GS + (size_t)M * 1024 * 2 <= WS_AST &&
              WS_AST + (size_t)2 * M * 512 * 2 <= WS_END && WS_WIN + (size_t)INW * 1024 * 2 <= WS_WST && WS_SSQ + (size_t)M * 16 * 4 <= WS_XN, "d_ws map");
constexpr int CW_TMO = 0, CW_BAR = 4096;

namespace pg8 {
#define PG8_LAS __attribute__((address_space(3)))
typedef unsigned short bf16_t;
typedef short bf16x8 __attribute__((ext_vector_type(8)));
typedef float f32x4 __attribute__((ext_vector_type(4)));
typedef unsigned u32x4 __attribute__((ext_vector_type(4)));
constexpr int BM = 256, BK = 64, HALF = 128, HTB = HALF * BK * 2  , STAGE_BYTES = 8 * HTB, NXCD = 8, WGM = 8;

__host__ __device__ __forceinline__ int lds_byte(int r, int c) { const int st = (r >> 4) * 2 + (c >> 5), rr = r & 15, cc = c & 31, ob = rr * 64 + cc * 2; return st * 1024 + (ob ^ (((ob >> 9) & 1) << 5)); }
__host__ __device__ __forceinline__ void stage_rc(int b, int& R, int& C) { const int st = b / 1024, sb = b % 1024, swz = sb ^ (((sb >> 9) & 1) << 5); R = (st >> 1) * 16 + swz / 64; C = (st & 1) * 32 + (swz % 64) / 2; }
__host__ __device__ __forceinline__ int perm32(int rho) { const int n = rho >> 4, i = rho & 15; return 8 * (i >> 2) + 4 * n + (i & 3); }

struct Unit { int pm, pn; };
struct Gemm { const bf16_t* A; const bf16_t* Bt; int M, N, K; };

struct StaticOrder {
    int nM, nN, nwg, G, c;
    __host__ __device__ void init(int M, int N, int G_, int c_) { nM = M / BM; nN = N / BM; nwg = nM * nN; G = G_; c = c_; }
    __host__ __device__ bool next(int i, Unit& u) const {
        const long L = (long)i * G + c; if (L >= nwg) return false;
        int wgid = (int)L; { const int q = nwg / NXCD, r = nwg % NXCD, xcd = wgid % NXCD, off = wgid / NXCD; wgid = (xcd < r ? xcd * (q + 1) : r * (q + 1) + (xcd - r) * q) + off; }
        const int nig = WGM * nN, gid = wgid / nig, fm = gid * WGM, gsz = (nM - fm) < WGM ? (nM - fm) : WGM;
        u.pm = fm + ((wgid % nig) % gsz); u.pn = (wgid % nig) / gsz; return true;
    }
    __device__ __forceinline__ void a_ready(const Unit&) const {}
    __device__ __forceinline__ void done(const Unit&) const {}
};


struct PairOrder {
    StaticOrder base; int dM, dN;
    __host__ __device__ bool next(int i, Unit& u) const { if (!base.next(i >> 1, u)) return false; if (i & 1) { u.pm += dM; u.pn += dN; } return true; }
    __device__ __forceinline__ void a_ready(const Unit&) const {}
    __device__ __forceinline__ void done(const Unit&) const {}
};

__device__ __forceinline__ u32x4 pack8(const f32x4 a, const f32x4 b) { u32x4 w; w.x = cvtpk_s(a[0], a[1]); w.y = cvtpk_s(a[2], a[3]); w.z = cvtpk_s(b[0], b[1]); w.w = cvtpk_s(b[2], b[3]); return w; }
__device__ __forceinline__ void unpack8(const u32x4 w, f32x4& a, f32x4& b) { a[0] = bf_lo(w.x); a[1] = bf_hi(w.x); a[2] = bf_lo(w.y); a[3] = bf_hi(w.y); b[0] = bf_lo(w.z); b[1] = bf_hi(w.z); b[2] = bf_lo(w.w); b[3] = bf_hi(w.w); }

struct EpiIn {
    static constexpr bool PERM = true, AFTER_DRAIN = false, CHAIN = false;
    unsigned char* ws; float* out;
    __device__ __forceinline__ void operator()(f32x4 (&acc)[2][2][4][2], const Unit& u, int wr, int wc, int fr, int fq) const {
        bf16_t* const Q = (bf16_t*)(ws + WS_Q); bf16_t* const Kb = (bf16_t*)(ws + WS_K); bf16_t* const Vb = (bf16_t*)(ws + WS_V); bf16_t* const ZA = (bf16_t*)(ws + WS_ZA);
        bf16_t* const U = (bf16_t*)(ws + WS_U); bf16_t* const ZS = (bf16_t*)(ws + WS_ZS); bf16_t* const GA = (bf16_t*)(ws + WS_GA); bf16_t* const GS = (bf16_t*)(ws + WS_GS);
        const float* const rope = (const float*)(ws + WS_ROPE);
        const int pn = u.pn;
        const int rowb = u.pm * BM + wr * 64 + fr;
        const int cw = wc * 32 + 8 * fq;
        bf16_t* dst; int ld, cbase, mode;
        if (pn < 2)       { dst = Q;  ld = 512;  cbase = pn * 256;        mode = 3; }
        else if (pn == 2) { dst = Kb; ld = 128;  cbase = 0;               mode = 4; }
        else if (pn < 5)  { dst = ZA; ld = 512;  cbase = (pn - 3) * 256;  mode = 1; }
        else if (pn < 7)  { dst = U;  ld = 512;  cbase = (pn - 5) * 256;  mode = 0; }
        else if (pn < 9)  { dst = ZS; ld = 512;  cbase = (pn - 7) * 256;  mode = 1; }
        else if (pn < 13) { dst = GA; ld = 1024; cbase = (pn - 9) * 256;  mode = 2; }
        else              { dst = GS; ld = 1024; cbase = (pn - 13) * 256; mode = 2; }
        const bool ropew = ((wc & 1) == 0);
#pragma unroll
        for (int ai = 0; ai < 2; ++ai)
#pragma unroll
            for (int m = 0; m < 4; ++m) {
                const int row = rowb + ai * HALF + m * 16;
                const int pos = row < MP ? (row & (SEQ - 1)) : PAST + ((row - MP) & (DSEQ - 1));
#pragma unroll
                for (int bj = 0; bj < 2; ++bj) {
                    f32x4 v0 = acc[ai][bj][m][0], v1 = acc[ai][bj][m][1];
                    if (mode == 1) {
#pragma unroll
                        for (int j = 0; j < 4; ++j) { v0[j] = silu_f(v0[j]); v1[j] = silu_f(v1[j]); }
                    } else if (mode == 2) {
#pragma unroll
                        for (int j = 0; j < 4; ++j) { v0[j] = sigmoid_f(v0[j]); v1[j] = sigmoid_f(v1[j]); }
                    } else if (mode == 3 || (mode == 4 && bj == 0)) {
                        if (ropew) {
                            f32x4 p0, p1;
#pragma unroll
                            for (int j = 0; j < 4; ++j) { p0[j] = __shfl_xor(v0[j], 16); p1[j] = __shfl_xor(v1[j], 16); }
                            if (fq < 2) {
                                const f32x4* cs = (const f32x4*)(rope + (size_t)pos * 16);
                                const f32x4 c01 = cs[0], c23 = cs[1], c45 = cs[2], c67 = cs[3];
                                const float sg = fq == 0 ? -1.f : 1.f;
                                v0[0] = v0[0] * c01[0] + sg * p0[0] * c01[1]; v0[1] = v0[1] * c01[2] + sg * p0[1] * c01[3];
                                v0[2] = v0[2] * c23[0] + sg * p0[2] * c23[1]; v0[3] = v0[3] * c23[2] + sg * p0[3] * c23[3];
                                v1[0] = v1[0] * c45[0] + sg * p1[0] * c45[1]; v1[1] = v1[1] * c45[2] + sg * p1[1] * c45[3];
                                v1[2] = v1[2] * c67[0] + sg * p1[2] * c67[1]; v1[3] = v1[3] * c67[2] + sg * p1[3] * c67[3];
                            }
                        }
                    }
                    if (mode == 4) {
                        bf16_t* d2 = bj == 0 ? Kb : Vb;
                        *(u32x4*)(d2 + (size_t)row * 128 + cw) = pack8(v0, v1);
                        float* w = nullptr;
                        if (u.pm >= MP / BM) { const int rs = row - MP; w = out + (bj == 0 ? OFF_KS : OFF_VS) + ((size_t)((rs >> 6) * 128 + 64 + (rs & 63))) * 128 + cw; }
                        else if ((u.pm & 7) == 7 && ai == 1) { const int t = row & (SEQ - 1); w = out + (bj == 0 ? OFF_KP : OFF_VP) + ((size_t)((row >> 11) * 128 + (t - (SEQ - 128)))) * 128 + cw; }
                        if (w) { *(f32x4*)w = v0; *(f32x4*)(w + 4) = v1; }
                    } else {
                        *(u32x4*)(dst + (size_t)row * ld + cbase + bj * HALF + cw) = pack8(v0, v1);
                    }
                }
            }
    }
};

struct EpiMerge {
    static constexpr bool PERM = true, AFTER_DRAIN = false, CHAIN = true;
    unsigned char* ws;
    static constexpr int nMt = M / BM;
    __device__ __forceinline__ void operator()(f32x4 (&acc)[2][2][4][2], const Unit& u, int wr, int wc, int fr, int fq) const {
        const bf16_t* const GA = (const bf16_t*)(ws + WS_GA); const bf16_t* const GS = (const bf16_t*)(ws + WS_GS); bf16_t* const MG = (bf16_t*)(ws + WS_XN);
        const bool second = u.pn >= 4;
        const int pm = second ? u.pm - nMt : u.pm, pn = second ? u.pn - 4 : u.pn;
        const int rowb = pm * BM + wr * 64 + fr, colb = pn * BM + wc * 32 + 8 * fq;
#pragma unroll
        for (int ai = 0; ai < 2; ++ai)
#pragma unroll
            for (int m = 0; m < 4; ++m) {
                const size_t ro = (size_t)(rowb + ai * HALF + m * 16) * DM + colb;
#pragma unroll
                for (int bj = 0; bj < 2; ++bj) {
                    f32x4 s0, s1; unpack8(*(const u32x4*)(GS + ro + bj * HALF), s0, s1);
                    if (!second) {
                        f32x4 a0, a1; unpack8(*(const u32x4*)(GA + ro + bj * HALF), a0, a1);
#pragma unroll
                        for (int j = 0; j < 4; ++j) { acc[ai][bj][m][0][j] *= a0[j] * __builtin_amdgcn_rcpf(s0[j]); acc[ai][bj][m][1][j] *= a1[j] * __builtin_amdgcn_rcpf(s1[j]); }
                    } else {
                        *(u32x4*)(MG + ro + bj * HALF) = pack8(acc[ai][bj][m][0] * s0, acc[ai][bj][m][1] * s1);
                    }
                }
                asm volatile("" ::: "memory");
            }
    }
};

struct EpiH1 {
    static constexpr bool PERM = true, AFTER_DRAIN = false, CHAIN = false;
    const float *xp, *xs; float* out; unsigned char* ws;
    __device__ __forceinline__ void operator()(f32x4 (&acc)[2][2][4][2], const Unit& u, int wr, int wc, int fr, int fq) const {
        bf16_t* const H1B = (bf16_t*)(ws + WS_GA);
        const int rowb = u.pm * BM + wr * 64 + fr, colb = u.pn * BM + wc * 32 + 8 * fq;
        const float* xb = u.pm < MP / BM ? xp : xs - (size_t)MP * DM;
#pragma unroll
        for (int ai = 0; ai < 2; ++ai)
#pragma unroll
            for (int m = 0; m < 4; ++m) {
                const size_t ro = (size_t)(rowb + ai * HALF + m * 16) * DM + colb;
#pragma unroll
                for (int bj = 0; bj < 2; ++bj) {
                    const f32x4 h0 = *(const f32x4*)(xb + ro + bj * HALF) + acc[ai][bj][m][0], h1 = *(const f32x4*)(xb + ro + bj * HALF + 4) + acc[ai][bj][m][1];
                    *(f32x4*)(out + ro + bj * HALF) = h0; *(f32x4*)(out + ro + bj * HALF + 4) = h1;
                    *(u32x4*)(H1B + ro + bj * HALF) = pack8(h0, h1);
                }
                asm volatile("" ::: "memory");
            }
    }
};

struct EpiPP {
    static constexpr bool PERM = true, AFTER_DRAIN = false, CHAIN = false;
    unsigned char* ws;
    __device__ __forceinline__ void operator()(f32x4 (&acc)[2][2][4][2], const Unit& u, int wr, int wc, int fr, int fq) const {
        bf16_t* const PP = (bf16_t*)(ws + WS_GS);
        const int rowb = u.pm * BM + wr * 64 + fr, colb = u.pn * BM + wc * 32 + 8 * fq;
#pragma unroll
        for (int ai = 0; ai < 2; ++ai)
#pragma unroll
            for (int m = 0; m < 4; ++m) {
                const size_t ro = (size_t)(rowb + ai * HALF + m * 16) * DM + colb;
#pragma unroll
                for (int bj = 0; bj < 2; ++bj) *(u32x4*)(PP + ro + bj * HALF) = pack8(acc[ai][bj][m][0], acc[ai][bj][m][1]);
            }
    }
};

struct EpiH2 {
    static constexpr bool PERM = true, AFTER_DRAIN = false, CHAIN = false;
    float* out; unsigned char* ws;
    __device__ __forceinline__ void operator()(f32x4 (&acc)[2][2][4][2], const Unit& u, int wr, int wc, int fr, int fq) const {
        const bf16_t* const PP = (const bf16_t*)(ws + WS_GS); float* const ssq = (float*)(ws + WS_SSQ);
        const int rowb = u.pm * BM + wr * 64 + fr, colb = u.pn * BM + wc * 32 + 8 * fq;
#pragma unroll
        for (int ai = 0; ai < 2; ++ai)
#pragma unroll
            for (int m = 0; m < 4; ++m) {
                const int row = rowb + ai * HALF + m * 16;
                const size_t ro = (size_t)row * DM + colb;
                float sq = 0.f;
#pragma unroll
                for (int bj = 0; bj < 2; ++bj) {
                    f32x4 p0, p1; unpack8(*(const u32x4*)(PP + ro + bj * HALF), p0, p1);
                    f32x4 h0 = *(const f32x4*)(out + ro + bj * HALF), h1 = *(const f32x4*)(out + ro + bj * HALF + 4);
#pragma unroll
                    for (int j = 0; j < 4; ++j) { h0[j] += sigmoid_f(acc[ai][bj][m][0][j]) * p0[j]; h1[j] += sigmoid_f(acc[ai][bj][m][1][j]) * p1[j]; sq += h0[j] * h0[j] + h1[j] * h1[j]; }
                    *(f32x4*)(out + ro + bj * HALF) = h0; *(f32x4*)(out + ro + bj * HALF + 4) = h1;
                }
                sq += __shfl_xor(sq, 16); sq += __shfl_xor(sq, 32);
                if (fq == 0) ssq[(size_t)row * 16 + u.pn * 4 + wc] = sq;
                asm volatile("" ::: "memory");
            }
    }
};

template <class Epi, class Sched, bool ALIGN_EPI = false, bool SP2 = false>
__device__ __forceinline__ void gemm_phase(PG8_LAS unsigned char* lds, const Gemm g, const Sched& S, const Epi& E) {
    int tid = threadIdx.x; asm volatile("" : "+v"(tid));
    const int wid = __builtin_amdgcn_readfirstlane(tid >> 6), lane = tid & 63, wr = wid >> 2, wc = wid & 3, fr = lane & 15, fq = lane >> 4;
    int K = g.K; asm volatile("" : "+s"(K));
    const int nt = K / BK;
    unsigned voffA[2], voffB[2];
#pragma unroll
    for (int i = 0; i < 2; ++i) { int R, C; stage_rc(tid * 16 + i * 8192, R, C); const int Rb = Epi::PERM ? ((R & ~31) + perm32(R & 31)) : R;
        voffA[i] = (unsigned)(R * K + C) * 2u; voffB[i] = (unsigned)(Rb * K + C) * 2u; }
    const size_t kstep = (size_t)(BK * 2);
    const size_t hstep = (size_t)HALF * K * 2;
    const size_t tstep = 2 * hstep;
    const unsigned ldsw = (unsigned)wid * 1024u;
    const int aoff = lds_byte(wr * 64 + fr, fq * 8), boff = lds_byte(wc * 32 + fr, fq * 8);
#define PG8_SA(b, h) (((b) * 2 + (h)) * HTB)
#define PG8_SB(b, h) ((4 + (b) * 2 + (h)) * HTB)
#define PG8_STAGE(bufoff, gbase, voff) do { _Pragma("unroll") for (int _i = 0; _i < 2; ++_i) \
        __builtin_amdgcn_global_load_lds((const unsigned*)((const char*)(gbase) + (voff)[_i]), (PG8_LAS unsigned*)(lds + (bufoff) + ldsw + _i * 8192), 16, 0, 0); } while (0)
#define PG8_LDA(dst, b, h) do { _Pragma("unroll") for (int m = 0; m < 4; ++m) _Pragma("unroll") for (int k = 0; k < 2; ++k) dst[m][k] = *(const PG8_LAS bf16x8*)(lds + PG8_SA(b, h) + aoff + m * 2048 + k * 1024); } while (0)
#define PG8_LDB(dst, b, h) do { _Pragma("unroll") for (int n = 0; n < 2; ++n) _Pragma("unroll") for (int k = 0; k < 2; ++k) dst[n][k] = *(const PG8_LAS bf16x8*)(lds + PG8_SB(b, h) + boff + n * 2048 + k * 1024); } while (0)
#define PG8_MMA(ai, bj, At, Bt) do { __builtin_amdgcn_s_setprio(1); _Pragma("unroll") for (int m = 0; m < 4; ++m) _Pragma("unroll") for (int n = 0; n < 2; ++n) _Pragma("unroll") for (int k = 0; k < 2; ++k) \
        acc[ai][bj][m][n] = __builtin_amdgcn_mfma_f32_16x16x32_bf16(Bt[n][k], At[m][k], acc[ai][bj][m][n], 0, 0, 0); __builtin_amdgcn_s_setprio(0); } while (0)
#define PG8_WAIT_V(n) asm volatile("s_waitcnt vmcnt(" #n ")" ::: "memory")
#define PG8_WAIT_L(n) asm volatile("s_waitcnt lgkmcnt(" #n ")" ::: "memory")
#define PG8_BAR __builtin_amdgcn_s_barrier()
#define PG8_SCHED __builtin_amdgcn_sched_barrier(0)
    Unit cur, nxt; int ui = 0;
    if (!S.next(0, cur)) return;
    f32x4 acc[2][2][4][2];
#pragma unroll
    for (int a = 0; a < 2; ++a)
#pragma unroll
        for (int b = 0; b < 2; ++b)
#pragma unroll
            for (int m = 0; m < 4; ++m)
#pragma unroll
                for (int n = 0; n < 2; ++n) acc[a][b][m][n] = (f32x4){0.f, 0.f, 0.f, 0.f};
    bf16x8 At[4][2], B0[2][2], B1[2][2];
    const char* cA = (const char*)g.A + (size_t)cur.pm * tstep; const char* cB = (const char*)g.Bt + (size_t)cur.pn * tstep;
    S.a_ready(cur);
    if constexpr (SP2) {
        PG8_STAGE(PG8_SB(0, 0), cB, voffB); PG8_STAGE(PG8_SB(0, 1), cB + hstep, voffB); PG8_STAGE(PG8_SA(0, 0), cA, voffA); PG8_STAGE(PG8_SA(0, 1), cA + hstep, voffA);
        if (wr == 1) PG8_BAR;
        PG8_WAIT_V(2); PG8_BAR;
        PG8_STAGE(PG8_SB(1, 0), cB + kstep, voffB); PG8_STAGE(PG8_SA(1, 0), cA + kstep, voffA); PG8_STAGE(PG8_SB(1, 1), cB + hstep + kstep, voffB);
        PG8_WAIT_V(6); PG8_BAR;
    } else {
        PG8_STAGE(PG8_SB(0, 0), cB, voffB); PG8_STAGE(PG8_SA(0, 0), cA, voffA); PG8_STAGE(PG8_SB(0, 1), cB + hstep, voffB); PG8_STAGE(PG8_SA(0, 1), cA + hstep, voffA);
        if (wr == 1) PG8_BAR;
        PG8_WAIT_V(4); PG8_BAR;
        PG8_STAGE(PG8_SB(1, 0), cB + kstep, voffB); PG8_STAGE(PG8_SA(1, 0), cA + kstep, voffA); PG8_STAGE(PG8_SB(1, 1), cB + hstep + kstep, voffB);
        PG8_WAIT_V(6); PG8_BAR;
    }
    for (;;) {
        const bool has_next = S.next(ui + 1, nxt);
        const char* nA = has_next ? (const char*)g.A + (size_t)nxt.pm * tstep : cA; const char* nB = has_next ? (const char*)g.Bt + (size_t)nxt.pn * tstep : cB;
        for (int t = 0; t < nt; t += 2) {
            const bool last = (t == nt - 2);
            const char* a1 = cA + (size_t)(t + 1) * kstep;
            const char* a2 = last ? nA : cA + (size_t)(t + 2) * kstep; const char* b2 = last ? nB : cB + (size_t)(t + 2) * kstep;
            const char* a3 = a2 + kstep; const char* b3 = b2 + kstep;
            if (last && has_next) S.a_ready(nxt);
            if constexpr (SP2) {
            PG8_LDB(B0, 0, 0); PG8_LDB(B1, 0, 1); PG8_SCHED; PG8_LDA(At, 0, 0); PG8_STAGE(PG8_SA(1, 1), a1 + hstep, voffA);
            PG8_WAIT_V(8); PG8_WAIT_L(0); PG8_BAR; PG8_MMA(0, 0, At, B0); PG8_MMA(0, 1, At, B1); PG8_BAR; PG8_SCHED;
            PG8_LDA(At, 0, 1); PG8_STAGE(PG8_SB(0, 0), b2, voffB); PG8_STAGE(PG8_SB(0, 1), b2 + hstep, voffB); PG8_STAGE(PG8_SA(0, 0), a2, voffA);
            PG8_WAIT_V(8); PG8_WAIT_L(0); PG8_BAR; PG8_MMA(1, 0, At, B0); PG8_MMA(1, 1, At, B1); PG8_BAR; PG8_SCHED;
            PG8_LDB(B0, 1, 0); PG8_LDB(B1, 1, 1); PG8_SCHED; PG8_LDA(At, 1, 0); PG8_STAGE(PG8_SA(0, 1), a2 + hstep, voffA);
            PG8_WAIT_V(8); PG8_WAIT_L(0); PG8_BAR; PG8_MMA(0, 0, At, B0); PG8_MMA(0, 1, At, B1); PG8_BAR; PG8_SCHED;
            PG8_LDA(At, 1, 1); PG8_STAGE(PG8_SB(1, 0), b3, voffB); PG8_STAGE(PG8_SB(1, 1), b3 + hstep, voffB); PG8_STAGE(PG8_SA(1, 0), a3, voffA);
            PG8_WAIT_V(8); PG8_WAIT_L(0); PG8_BAR; PG8_MMA(1, 0, At, B0); PG8_MMA(1, 1, At, B1); PG8_BAR; PG8_SCHED;
            } else {
            PG8_LDB(B0, 0, 0); PG8_SCHED; PG8_LDA(At, 0, 0); PG8_STAGE(PG8_SA(1, 1), a1 + hstep, voffA);
            PG8_WAIT_L(8); PG8_BAR; PG8_WAIT_L(0); PG8_MMA(0, 0, At, B0); PG8_BAR; PG8_SCHED;
            PG8_LDB(B1, 0, 1); PG8_STAGE(PG8_SB(0, 0), b2, voffB);
            PG8_BAR; PG8_WAIT_L(0); PG8_MMA(0, 1, At, B1); PG8_BAR;
            PG8_LDA(At, 0, 1); PG8_STAGE(PG8_SA(0, 0), a2, voffA);
            PG8_BAR; PG8_WAIT_L(0); PG8_MMA(1, 0, At, B0); PG8_BAR; PG8_SCHED;
            PG8_STAGE(PG8_SB(0, 1), b2 + hstep, voffB);
            PG8_WAIT_V(6); PG8_BAR; PG8_MMA(1, 1, At, B1); PG8_BAR;
            PG8_LDB(B0, 1, 0); PG8_SCHED; PG8_LDA(At, 1, 0); PG8_STAGE(PG8_SA(0, 1), a2 + hstep, voffA);
            PG8_WAIT_L(8); PG8_BAR; PG8_WAIT_L(0); PG8_MMA(0, 0, At, B0); PG8_BAR; PG8_SCHED;
            PG8_LDB(B1, 1, 1); PG8_STAGE(PG8_SB(1, 0), b3, voffB);
            PG8_BAR; PG8_WAIT_L(0); PG8_MMA(0, 1, At, B1); PG8_BAR;
            PG8_LDA(At, 1, 1); PG8_STAGE(PG8_SA(1, 0), a3, voffA);
            PG8_BAR; PG8_WAIT_L(0); PG8_MMA(1, 0, At, B0); PG8_BAR; PG8_SCHED;
            PG8_STAGE(PG8_SB(1, 1), b3 + hstep, voffB);
            PG8_WAIT_V(6); PG8_BAR; PG8_MMA(1, 1, At, B1); PG8_BAR;
            }
        }
        if constexpr (ALIGN_EPI) { if (wr == 0) PG8_BAR; }
        if constexpr (!Epi::AFTER_DRAIN) { E(acc, cur, wr, wc, fr, fq); S.done(cur); }
        if (!has_next) break;
        if (!(Epi::CHAIN && (ui & 1) == 0)) {
#pragma unroll
        for (int a = 0; a < 2; ++a)
#pragma unroll
            for (int b = 0; b < 2; ++b)
#pragma unroll
                for (int m = 0; m < 4; ++m)
#pragma unroll
                    for (int n = 0; n < 2; ++n) acc[a][b][m][n] = (f32x4){0.f, 0.f, 0.f, 0.f};
        }
        cur = nxt; cA = nA; cB = nB; ++ui;
        if constexpr (ALIGN_EPI) { if (wr == 1) PG8_BAR; }
    }
    PG8_WAIT_V(0);
    if constexpr (!ALIGN_EPI) { if (wr == 0) PG8_BAR; }
    PG8_BAR;
    if constexpr (Epi::AFTER_DRAIN) { E.fused(acc, cur, wr, wc, fr, fq, lds, wid, lane); S.done(cur); }
#undef PG8_SA
#undef PG8_SB
#undef PG8_STAGE
#undef PG8_LDA
#undef PG8_LDB
#undef PG8_MMA
#undef PG8_WAIT_V
#undef PG8_WAIT_L
#undef PG8_BAR
#undef PG8_SCHED
}
}


constexpr int NWAVES = 8;
#ifndef MK_N_LAUNCHES
#define MK_N_LAUNCHES 1
#endif
constexpr int N_PHASES = 8;
constexpr int N_LAUNCHES = MK_N_LAUNCHES;

constexpr int RING_BYTES = 131072;
constexpr int KL_STRIDE = 144, VT_STRIDE = 400;
constexpr int LDS_KL = 0, LDS_VT = 192 * KL_STRIDE;
constexpr int ZL_STRIDE = 1040, HL_STRIDE = 272;
constexpr int LDS_ZL = 0, LDS_HL = 64 * ZL_STRIDE  , HL_WAVE = 32 * HL_STRIDE  , LDS_HP = LDS_HL + NWAVES * HL_WAVE  , LDS_P3_END = LDS_HP + 16384  ;
constexpr int MISC_OFF = LDS_P3_END;
constexpr int LDS_BYTES = 153600;
static_assert(MISC_OFF + 512 <= LDS_BYTES && LDS_VT + 64 * VT_STRIDE <= RING_BYTES, "LDS map");

#define GAS __attribute__((address_space(1)))
#define LAS __attribute__((address_space(3)))
typedef unsigned short bf16;
typedef unsigned v4u __attribute__((ext_vector_type(4)));
typedef unsigned v2u __attribute__((ext_vector_type(2)));
typedef float f32x4 __attribute__((ext_vector_type(4)));
typedef float f32x16 __attribute__((ext_vector_type(16)));
typedef short bf16x8 __attribute__((ext_vector_type(8)));
typedef GAS unsigned gu32;
#define RLX_AGENT __ATOMIC_RELAXED, __HIP_MEMORY_SCOPE_AGENT
#define LDS_WAIT() asm volatile("s_waitcnt lgkmcnt(0)" ::: "memory")
#define VM_WAIT() asm volatile("s_waitcnt vmcnt(0)" ::: "memory")
__device__ __forceinline__ unsigned pk2(float lo, float hi) { return cvtpk_s(lo, hi); }
__device__ __forceinline__ bf16 f2bf(float f) { return (bf16)(cvtpk_s(f, 0.f) & 0xffffu); }

#define XB_TMO      128
#define XB_XCNT(j)  (256  + 64 * (j))
#define XB_XSUB(j)  (1280 + 64 * (j))
#define XB_XGEN(j)  (2304 + 64 * (j))
#define XB_TOP      3328
#define XB_TOPGEN   3392
#define XCD_BAR_WORDS 3456
#define XB_SPIN_CAP (1u << 18)

__device__ __forceinline__ unsigned xb_ld(unsigned* p)              { return __hip_atomic_load(p, __ATOMIC_RELAXED, __HIP_MEMORY_SCOPE_AGENT); }
__device__ __forceinline__ unsigned xb_add(unsigned* p, unsigned v) { return __hip_atomic_fetch_add(p, v, __ATOMIC_RELAXED, __HIP_MEMORY_SCOPE_AGENT); }
__device__ __forceinline__ unsigned xb_xcc_id() { return (unsigned)__builtin_amdgcn_s_getreg((3 << 11) | 20) & 0xFu; }
#define XB_SPIN(cond, bar) do { unsigned _sp = 0; while (cond) { __builtin_amdgcn_s_sleep(1); \
    if ((++_sp & 255u) == 0u) { if (xb_ld(&(bar)[XB_TMO])) break; if (_sp > XB_SPIN_CAP) { atomicAdd(&(bar)[XB_TMO], 1u); break; } } } } while (0)

struct XcdBarrier { unsigned* bar; unsigned x; volatile LAS unsigned* st; };

__device__ __forceinline__ XcdBarrier xcd_barrier_post(unsigned* bar, volatile LAS unsigned* st) {
    XcdBarrier b; b.bar = bar; b.x = xb_xcc_id(); b.st = st;
    if (threadIdx.x == 0) (void)xb_add(&bar[XB_XCNT(b.x)], 1u);
    return b;
}
__device__ __forceinline__ void xcd_barrier_complete(unsigned* bar, unsigned x, unsigned& nloc, unsigned& nx) {
    const unsigned G = gridDim.x * gridDim.y * gridDim.z;
    unsigned sum, cnt, mine, sp = 0u;
    for (;;) {
        sum = 0u; cnt = 0u; mine = 0u;
#pragma unroll
        for (unsigned j = 0; j < 16; ++j) { const unsigned c = xb_ld(&bar[XB_XCNT(j)]); sum += c; cnt += (c > 0u) ? 1u : 0u; mine = (j == x) ? c : mine; }
        if (sum == G) break;
        __builtin_amdgcn_s_sleep(1);
        if ((++sp & 255u) == 0u) { if (xb_ld(&bar[XB_TMO])) break; if (sp > XB_SPIN_CAP) { atomicAdd(&bar[XB_TMO], 1u); break; } }
    }
    nloc = mine > 0u ? mine : 1u; nx = cnt > 0u ? cnt : 1u;
}
__device__ __forceinline__ void xcd_barrier(const XcdBarrier& b) {
    asm volatile("s_waitcnt vmcnt(0)" ::: "memory");
    __syncthreads();
    if (threadIdx.x == 0) {
        unsigned* bar = b.bar;
        __builtin_amdgcn_s_waitcnt(0);
        unsigned nloc = b.st[0], nx = b.st[1];
        if (nloc == 0u) { xcd_barrier_complete(bar, b.x, nloc, nx); b.st[0] = nloc; b.st[1] = nx; }
        const unsigned old = xb_add(&bar[XB_XSUB(b.x)], 1u);
        const unsigned gen = old / nloc;
        if (old + 1u == (gen + 1u) * nloc) {
            __builtin_amdgcn_fence(__ATOMIC_RELEASE, "agent");
            asm volatile("s_waitcnt vmcnt(0)" ::: "memory");
            const unsigned og = xb_add(&bar[XB_TOP], 1u);
            const unsigned tg = og / nx;
            if (og + 1u == (tg + 1u) * nx) xb_add(&bar[XB_TOPGEN], 1u);
            else XB_SPIN(xb_ld(&bar[XB_TOPGEN]) == tg, bar);
            __builtin_amdgcn_fence(__ATOMIC_ACQUIRE, "agent");
            xb_add(&bar[XB_XGEN(b.x)], 1u);
            asm volatile("s_waitcnt vmcnt(0)" ::: "memory");
        } else {
            XB_SPIN(xb_ld(&bar[XB_XGEN(b.x)]) == gen, bar);
            __builtin_amdgcn_fence(__ATOMIC_ACQUIRE, "agent");
            asm volatile("s_waitcnt vmcnt(0)" ::: "memory");
        }
    }
    __syncthreads();
}

struct Args {
    const float *x_prompt, *x_sample, *p_prompt, *p_sample, *cache_k, *cache_v, *st_re, *st_im, *norm_gain, *w_in, *sinks, *w_o_attn,
                *a_re, *a_im, *log_dt, *b_re, *b_im, *c_re, *c_im, *ssm_d, *w_glu, *w_o_ssm, *w_out, *w_pg, *w_pp, *fgain;
    float* out; unsigned char* ws; int ph_lo, ph_hi;
};
typedef const __attribute__((address_space(4))) Args* AP;
__device__ __forceinline__ AP args_ptr() { AP p = (AP)__builtin_amdgcn_kernarg_segment_ptr(); asm volatile("" : "+s"(p)); return p; }

__device__ __forceinline__ float wave_sum(float v) {
#pragma unroll
    for (int o = 1; o < 64; o <<= 1) v += __shfl_xor(v, o);
    return v;
}
__device__ __forceinline__ void p0_transpose_item(const float* W, int K, int N, bf16* WT, int row_off, LAS float* scr, int item, int lane) {
    const int nblk = N / 32, kb = item / nblk, nb = item % nblk, k0 = 64 * kb, n0 = 32 * nb;
#pragma unroll 8
    for (int i = 0; i < 32; ++i) { const int kk = 2 * i + (lane >> 5); scr[kk * 33 + (lane & 31)] = W[(size_t)(k0 + kk) * N + n0 + (lane & 31)]; }
    LDS_WAIT(); asm volatile("" ::: "memory");
    const int c = lane & 7;
#pragma unroll
    for (int j = 0; j < 4; ++j) { const int n = (lane >> 3) + 8 * j; const LAS float* s = scr + (8 * c) * 33 + n;
        v4u o; o.x = pk2(s[0 * 33], s[1 * 33]); o.y = pk2(s[2 * 33], s[3 * 33]); o.z = pk2(s[4 * 33], s[5 * 33]); o.w = pk2(s[6 * 33], s[7 * 33]);
        *(GAS v4u*)(WT + (size_t)(row_off + n0 + n) * K + k0 + 8 * c) = o; }
    LDS_WAIT(); asm volatile("" ::: "memory");
}
__device__ __forceinline__ void rms_row_to_bf16(const float* xrow, const float* gain, bf16* orow, int lane) {
    const GAS f32x4* xr = (const GAS f32x4*)xrow + lane; const GAS f32x4* gr = (const GAS f32x4*)gain + lane;
    f32x4 v[4]; float s = 0.f;
#pragma unroll
    for (int j = 0; j < 4; ++j) { v[j] = xr[64 * j]; s += (v[j].x * v[j].x + v[j].y * v[j].y) + (v[j].z * v[j].z + v[j].w * v[j].w); }
    const float r = 1.f / sqrtf(wave_sum(s) * (1.f / DM) + EPS);
    GAS v2u* o8 = (GAS v2u*)orow + lane;
#pragma unroll
    for (int j = 0; j < 4; ++j) { const f32x4 g = gr[64 * j]; v2u o; o.x = pk2(v[j].x * r * g.x, v[j].y * r * g.y); o.y = pk2(v[j].z * r * g.z, v[j].w * r * g.w); o8[64 * j] = o; }
}
__device__ __forceinline__ void sincos_d(double x, double& s, double& c) {
    const double k = __builtin_rint(x * 0.63661977236758134);
    double r = __builtin_fma(-k, 1.5707963267948966, x); r = __builtin_fma(-k, 6.123233995736766e-17, r);
    const int q = ((int)k) & 3;
    const double r2 = r * r;
    double sp = 1.0 / 355687428096000.0;
    sp = sp * r2 - 1.0 / 1307674368000.0; sp = sp * r2 + 1.0 / 6227020800.0; sp = sp * r2 - 1.0 / 39916800.0; sp = sp * r2 + 1.0 / 362880.0;
    sp = sp * r2 - 1.0 / 5040.0; sp = sp * r2 + 1.0 / 120.0; sp = sp * r2 - 1.0 / 6.0; sp = sp * r2 + 1.0; sp = sp * r;
    double cp = 1.0 / 20922789888000.0;
    cp = cp * r2 - 1.0 / 87178291200.0; cp = cp * r2 + 1.0 / 479001600.0; cp = cp * r2 - 1.0 / 3628800.0; cp = cp * r2 + 1.0 / 40320.0;
    cp = cp * r2 - 1.0 / 720.0; cp = cp * r2 + 1.0 / 24.0; cp = cp * r2 - 0.5; cp = cp * r2 + 1.0;
    s = (q == 0) ? sp : (q == 1) ? cp : (q == 2) ? -sp : -cp;
    c = (q == 0) ? cp : (q == 1) ? -sp : (q == 2) ? -cp : sp;
}
__device__ __forceinline__ double exp_d(double x) {
    const double k = __builtin_rint(x * 1.4426950408889634);
    double r = __builtin_fma(-k, 0.6931471805599453, x); r = __builtin_fma(-k, 2.3190468138462996e-17, r);
    double p = 1.0 / 6227020800.0;
    p = p * r + 1.0 / 479001600.0; p = p * r + 1.0 / 39916800.0; p = p * r + 1.0 / 3628800.0; p = p * r + 1.0 / 362880.0; p = p * r + 1.0 / 40320.0; p = p * r + 1.0 / 5040.0;
    p = p * r + 1.0 / 720.0; p = p * r + 1.0 / 120.0; p = p * r + 1.0 / 24.0; p = p * r + 1.0 / 6.0; p = p * r + 0.5; p = p * r + 1.0; p = p * r + 1.0;
    const long long bits = (long long)(1023 + (int)k) << 52;
    return p * __builtin_bit_cast(double, bits);
}
__device__ __forceinline__ double expm1_small_d(double x) {
    double p = 1.0 / 479001600.0;
    p = p * x + 1.0 / 39916800.0; p = p * x + 1.0 / 3628800.0; p = p * x + 1.0 / 362880.0; p = p * x + 1.0 / 40320.0; p = p * x + 1.0 / 5040.0;
    p = p * x + 1.0 / 720.0; p = p * x + 1.0 / 120.0; p = p * x + 1.0 / 24.0; p = p * x + 1.0 / 6.0; p = p * x + 0.5; p = p * x + 1.0;
    return p * x;
}

__device__ __forceinline__ void p0_prologue(AP a, LAS unsigned char* lds, int wave, int lane) {
    unsigned char* ws = a->ws;
    LAS float* scr = (LAS float*)(lds + wave * 16384);
    const int gw = blockIdx.x * NWAVES + wave, NGW = gridDim.x * NWAVES;
    const int gt = gw * 64 + lane, NGT = NGW * 64;
    constexpr int I_IN = (1024 / 64) * (INW / 32), I_OA = (512 / 64) * (1024 / 32), I_OS = I_OA, I_GL = (512 / 64) * (512 / 32), I_OUT = (1024 / 64) * (1024 / 32), I_PG = I_OUT, I_PP = (256 / 64) * (1024 / 32);
    constexpr int NITEMS = I_IN + I_OA + I_OS + I_GL + I_OUT + I_PG + I_PP;
    for (int it = gw; it < NITEMS; it += NGW) {
        int r = it;
        if (r < I_IN)  { p0_transpose_item(a->w_in, 1024, INW, (bf16*)(ws + WS_WIN), 0, scr, r, lane); continue; } r -= I_IN;
        if (r < I_OA)  { p0_transpose_item(a->w_o_attn, 512, 1024, (bf16*)(ws + WS_WST), 0, scr, r, lane); continue; } r -= I_OA;
        if (r < I_OS)  { p0_transpose_item(a->w_o_ssm, 512, 1024, (bf16*)(ws + WS_WST), 1024, scr, r, lane); continue; } r -= I_OS;
        if (r < I_GL)  { p0_transpose_item(a->w_glu, 512, 512, (bf16*)(ws + WS_WGLU), 0, scr, r, lane); continue; } r -= I_GL;
        if (r < I_OUT) { p0_transpose_item(a->w_out, 1024, 1024, (bf16*)(ws + WS_WOUT), 0, scr, r, lane); continue; } r -= I_OUT;
        if (r < I_PG)  { p0_transpose_item(a->w_pg, 1024, 1024, (bf16*)(ws + WS_WPG), 0, scr, r, lane); continue; } r -= I_PG;
        p0_transpose_item(a->w_pp, 256, 1024, (bf16*)(ws + WS_WPP), 0, scr, r, lane);
    }
    for (int m = gw; m < M; m += NGW) {
        const float* xrow = m < MP ? a->x_prompt + (size_t)m * DM : a->x_sample + (size_t)(m - MP) * DM;
        rms_row_to_bf16(xrow, a->norm_gain, (bf16*)(ws + WS_XN) + (size_t)m * DM, lane);
        const float* prow = m < MP ? a->p_prompt + (size_t)m * PLE : a->p_sample + (size_t)(m - MP) * PLE;
        const f32x4 pv = ((const GAS f32x4*)prow)[lane];
        v2u o; o.x = pk2(pv.x, pv.y); o.y = pk2(pv.z, pv.w);
        ((GAS v2u*)((bf16*)(ws + WS_P) + (size_t)m * PLE))[lane] = o;
    }
    for (int i = gt; i < 2 * 16384; i += NGT) {
        const int which = i >> 14, j = i & 16383, b = j >> 11, r = j & 2047;
        const float* src = (which ? a->cache_v : a->cache_k) + (size_t)b * 16384 + 8192;
        float* dst = a->out + (which ? OFF_VS : OFF_KS) + (size_t)b * 16384;
        ((GAS f32x4*)dst)[r] = ((const GAS f32x4*)src)[r];
    }
    for (int i = gt; i < 2048 * 8; i += NGT) {
        const int pos = i >> 3, f = i & 7;
        const double INV[8] = {1.0, 0.19392274474868576, 0.03760603093086393, 0.007292664737217109, 0.001414213562373095, 0.0002742481756762073, 5.318295896944988e-05, 1.031338537721246e-05};
        double inv = INV[0];
#pragma unroll
        for (int q = 1; q < 8; ++q) inv = (f == q) ? INV[q] : inv;
        const float ang = (float)pos * (float)inv;
        double s, c; sincos_d((double)ang, s, c);
        float* rt = (float*)(ws + WS_ROPE) + (size_t)i * 2; rt[0] = (float)c; rt[1] = (float)s;
    }
    for (int it = gt; it < 32 * 64; it += NGT) {
        const int g = it >> 6, p = it & 63;
        const double lr = (double)a->a_re[it], li = (double)a->a_im[it], dt = exp_d((double)a->log_dt[g]);
        const double xr = lr * dt, th = li * dt;
        double sn, cs, sh, ch; sincos_d(th, sn, cs); sincos_d(0.5 * th, sh, ch);
        const double em1 = expm1_small_d(xr), ex = em1 + 1.0;
        const double ar = ex * cs, ai = ex * sn;
        const double ur = em1 * cs - 2.0 * sh * sh, ui = ai;
        const double den = lr * lr + li * li;
        const double cr = (ur * lr + ui * li) / den, ci = (ui * lr - ur * li) / den;
        bf16* Bb = (bf16*)(ws + WS_SSMB);
#pragma unroll
        for (int c = 0; c < 16; ++c) {
            const double br = (double)a->b_re[(size_t)it * 16 + c], bi = (double)a->b_im[(size_t)it * 16 + c];
            Bb[(size_t)(g * 128 + p) * 16 + c] = f2bf((float)(cr * br - ci * bi));
            Bb[(size_t)(g * 128 + 64 + p) * 16 + c] = f2bf((float)(cr * bi + ci * br));
        }
        bf16* Cm = (bf16*)(ws + WS_SSMC);
        const int kq = 4 * (p & 31) + 2 * (p >> 5);
#pragma unroll
        for (int co = 0; co < 16; ++co) {
            Cm[(size_t)(g * 16 + co) * 128 + kq] = f2bf(a->c_re[(size_t)(g * 16 + co) * 64 + p]);
            Cm[(size_t)(g * 16 + co) * 128 + kq + 1] = f2bf(-a->c_im[(size_t)(g * 16 + co) * 64 + p]);
        }
        float* ap = (float*)(ws + WS_APOW) + (size_t)it * 12;
        const double a2r = ar * ar - ai * ai, a2i = 2.0 * ar * ai;
        const double a3r = a2r * ar - a2i * ai, a3i = a2r * ai + a2i * ar;
        const double a4r = a2r * a2r - a2i * a2i, a4i = 2.0 * a2r * a2i;
        const double a8r = a4r * a4r - a4i * a4i, a8i = 2.0 * a4r * a4i;
        double pr = a8r, pi = a8i;
#pragma unroll
        for (int q = 0; q < 3; ++q) { const double t = pr * pr - pi * pi; pi = 2.0 * pr * pi; pr = t; }
        ap[0] = (float)ar; ap[1] = (float)ai; ap[2] = (float)a2r; ap[3] = (float)a2i; ap[4] = (float)a3r; ap[5] = (float)a3i;
        ap[6] = (float)a4r; ap[7] = (float)a4i; ap[8] = (float)a8r; ap[9] = (float)a8i; ap[10] = (float)pr; ap[11] = (float)pi;
    }
}

#define MFMA32(a, b, c) __builtin_amdgcn_mfma_f32_32x32x16_bf16((a), (b), (c), 0, 0, 0)
#define MFMA16(a, b, c) __builtin_amdgcn_mfma_f32_16x16x32_bf16((a), (b), (c), 0, 0, 0)
__device__ __forceinline__ bf16x8 pack_regs8(const f32x16& x, const int s) {
    v4u p; p.x = cvtpk_s(x[8 * s + 0], x[8 * s + 1]); p.y = cvtpk_s(x[8 * s + 2], x[8 * s + 3]); p.z = cvtpk_s(x[8 * s + 4], x[8 * s + 5]); p.w = cvtpk_s(x[8 * s + 6], x[8 * s + 7]);
    return __builtin_bit_cast(bf16x8, p);
}
__device__ __forceinline__ void attn_unit(AP a, LAS unsigned char* lds, int unit, int tid, int wave, int lane) {
    asm volatile("" : "+v"(tid), "+v"(lane));
    unsigned char* ws = a->ws;
    const bf16* Qb = (const bf16*)(ws + WS_Q); const bf16* Kb = (const bf16*)(ws + WS_K); const bf16* Vb = (const bf16*)(ws + WS_V);
    const bf16* ZA = (const bf16*)(ws + WS_ZA); bf16* A1 = (bf16*)(ws + WS_AST);
    const int kvh = unit & 1;
    const bool smp = unit >= 512;
    const int cr = smp ? 256 + ((unit - 512) >> 1) : (unit >> 1);
    const int row0 = cr * 64, c = cr & 31;
    const int kb_lo = smp ? 0 : (c >= 2 ? 0 : (2 - c) * 2);
#pragma unroll
    for (int i = 0; i < 3; ++i) {
        const int q = tid + 512 * i, key = q >> 3, ch = q & 7;
        v4u kv = {0u, 0u, 0u, 0u}, vv = {0u, 0u, 0u, 0u};
        if (smp) {
            if (key < 128) {
                const size_t o = ((size_t)((cr - 256) * 128 + key) * 2 + kvh) * 64 + ch * 8;
                const f32x4 k0 = *(const GAS f32x4*)(a->cache_k + o), k1 = *(const GAS f32x4*)(a->cache_k + o + 4);
                const f32x4 v0 = *(const GAS f32x4*)(a->cache_v + o), v1 = *(const GAS f32x4*)(a->cache_v + o + 4);
                kv.x = pk2(k0.x, k0.y); kv.y = pk2(k0.z, k0.w); kv.z = pk2(k1.x, k1.y); kv.w = pk2(k1.z, k1.w);
                vv.x = pk2(v0.x, v0.y); vv.y = pk2(v0.z, v0.w); vv.z = pk2(v1.x, v1.y); vv.w = pk2(v1.z, v1.w);
            } else {
                const size_t o = (size_t)(row0 + key - 128) * 128 + kvh * 64 + ch * 8;
                kv = *(const GAS v4u*)(Kb + o); vv = *(const GAS v4u*)(Vb + o);
            }
        } else {
            const int kc = key >> 6;
            if (c - 2 + kc >= 0) {
                const size_t o = (size_t)(row0 + (kc - 2) * 64 + (key & 63)) * 128 + kvh * 64 + ch * 8;
                kv = *(const GAS v4u*)(Kb + o); vv = *(const GAS v4u*)(Vb + o);
            }
        }
        *(LAS v4u*)(lds + LDS_KL + key * KL_STRIDE + ch * 16) = kv;
        const int w = key & 15, pos = (key & ~15) | (w & 3) | ((w & 4) << 1) | ((w & 8) >> 1);
        LAS bf16* vt = (LAS bf16*)(lds + LDS_VT) + pos;
        const int d0 = ch * 8;
        vt[(d0 + 0) * (VT_STRIDE / 2)] = (bf16)(vv.x & 0xffffu); vt[(d0 + 1) * (VT_STRIDE / 2)] = (bf16)(vv.x >> 16);
        vt[(d0 + 2) * (VT_STRIDE / 2)] = (bf16)(vv.y & 0xffffu); vt[(d0 + 3) * (VT_STRIDE / 2)] = (bf16)(vv.y >> 16);
        vt[(d0 + 4) * (VT_STRIDE / 2)] = (bf16)(vv.z & 0xffffu); vt[(d0 + 5) * (VT_STRIDE / 2)] = (bf16)(vv.z >> 16);
        vt[(d0 + 6) * (VT_STRIDE / 2)] = (bf16)(vv.w & 0xffffu); vt[(d0 + 7) * (VT_STRIDE / 2)] = (bf16)(vv.w >> 16);
    }
    __syncthreads();
    const int hq = kvh * 4 + (wave >> 1), th = wave & 1, r32 = lane & 31, h = lane >> 5;
    const int qrow = row0 + th * 32 + r32;
    bf16x8 qf[4];
#pragma unroll
    for (int s = 0; s < 4; ++s) qf[s] = *(const GAS bf16x8*)(Qb + (size_t)qrow * 512 + hq * 64 + 16 * s + 8 * h);
    f32x16 st[6];
    const float SC = 0.125f * 1.4426950408889634f;
    const float sink2 = a->sinks[hq] * 1.4426950408889634f;
    float mx = sink2;
#pragma unroll
    for (int kb = 0; kb < 6; ++kb) {
#pragma unroll
        for (int r = 0; r < 16; ++r) st[kb][r] = 0.f;
        if (kb >= kb_lo) {
#pragma unroll
            for (int s = 0; s < 4; ++s) {
                const bf16x8 kf = *(const LAS bf16x8*)(lds + LDS_KL + (kb * 32 + r32) * KL_STRIDE + (16 * s + 8 * h) * 2);
                st[kb] = MFMA32(kf, qf[s], st[kb]);
            }
#pragma unroll
            for (int r = 0; r < 16; ++r) { st[kb][r] *= SC; mx = fmaxf(mx, st[kb][r]); }
        }
    }
    mx = fmaxf(mx, __shfl_xor(mx, 32));
    float sum = 0.f;
#pragma unroll
    for (int kb = 0; kb < 6; ++kb) {
        if (kb >= kb_lo) {
#pragma unroll
            for (int r = 0; r < 16; ++r) { const float e = __builtin_amdgcn_exp2f(st[kb][r] - mx); st[kb][r] = e; sum += e; }
        }
    }
    sum += __shfl_xor(sum, 32);
    const float inv = 1.0f / (sum + __builtin_amdgcn_exp2f(sink2 - mx));
    f32x16 o[2];
#pragma unroll
    for (int db = 0; db < 2; ++db)
#pragma unroll
        for (int r = 0; r < 16; ++r) o[db][r] = 0.f;
#pragma unroll
    for (int kb = 0; kb < 6; ++kb) {
        if (kb >= kb_lo) {
#pragma unroll
            for (int s = 0; s < 2; ++s) {
                const bf16x8 pf = pack_regs8(st[kb], s);
#pragma unroll
                for (int db = 0; db < 2; ++db) {
                    const bf16x8 vf = *(const LAS bf16x8*)(lds + LDS_VT + (db * 32 + r32) * VT_STRIDE + (kb * 32 + 16 * s + 8 * h) * 2);
                    o[db] = MFMA32(vf, pf, o[db]);
                }
            }
        }
    }
#pragma unroll
    for (int db = 0; db < 2; ++db)
#pragma unroll
        for (int g4 = 0; g4 < 4; ++g4) {
            const size_t off = (size_t)qrow * 512 + hq * 64 + db * 32 + 8 * g4 + 4 * h;
            const v2u z = *(const GAS v2u*)(ZA + off);
            v2u w; w.x = pk2(o[db][4 * g4 + 0] * inv * bf_lo(z.x), o[db][4 * g4 + 1] * inv * bf_hi(z.x)); w.y = pk2(o[db][4 * g4 + 2] * inv * bf_lo(z.y), o[db][4 * g4 + 3] * inv * bf_hi(z.y));
            *(GAS v2u*)(A1 + off) = w;
        }
    __syncthreads();
}

template <bool FULL>
__device__ __forceinline__ void ssm_group(AP a, LAS unsigned char* lds, int cr, int g, int wave, int lane) {
    asm volatile("" : "+v"(lane));
    unsigned char* ws = a->ws;
    const bf16* U = (const bf16*)(ws + WS_U); const bf16* Bb = (const bf16*)(ws + WS_SSMB); const bf16* Cm = (const bf16*)(ws + WS_SSMC);
    const float* apow = (const float*)(ws + WS_APOW);
    const int p32 = lane & 31, h = lane >> 5, row0 = cr * 64;
    LAS unsigned char* Hl = lds + LDS_HL + wave * HL_WAVE;
    const LAS float* Hp = (const LAS float*)(lds + LDS_HP);
    bf16x8 bb[4];
#pragma unroll
    for (int nb = 0; nb < 4; ++nb) bb[nb] = *(const GAS bf16x8*)(Bb + (size_t)(g * 128 + nb * 32 + p32) * 16 + 8 * h);
    float A1r[2], A1i[2], A2r[2], A2i[2], A3r[2], A3i[2], A4r[2], A4i[2], A8r[2], A8i[2], cyr[2], cyi[2];
#pragma unroll
    for (int pi = 0; pi < 2; ++pi) {
        const f32x4* ap = (const f32x4*)(apow + (size_t)(g * 64 + pi * 32 + p32) * 12);
        const f32x4 q0 = ap[0], q1 = ap[1], q2 = ap[2];
        A1r[pi] = q0[0]; A1i[pi] = q0[1]; A2r[pi] = q0[2]; A2i[pi] = q0[3]; A3r[pi] = q1[0]; A3i[pi] = q1[1]; A4r[pi] = q1[2]; A4i[pi] = q1[3]; A8r[pi] = q2[0]; A8i[pi] = q2[1];
        if (FULL) { cyr[pi] = Hp[g * 128 + pi * 32 + p32]; cyi[pi] = Hp[g * 128 + 64 + pi * 32 + p32]; } else { cyr[pi] = 0.f; cyi[pi] = 0.f; }
    }
    bf16x8 cmf[4];
    if (FULL) {
#pragma unroll
        for (int ks = 0; ks < 4; ++ks) cmf[ks] = *(const GAS bf16x8*)(Cm + (size_t)(g * 16 + (lane & 15)) * 128 + 32 * ks + 8 * (lane >> 4));
    }
#pragma unroll
    for (int tb = 0; tb < 2; ++tb) {
        const bf16x8 uf = *(const GAS bf16x8*)(U + (size_t)(row0 + tb * 32 + p32) * 512 + g * 16 + 8 * h);
        f32x16 x[4];
#pragma unroll
        for (int nb = 0; nb < 4; ++nb) {
#pragma unroll
            for (int r = 0; r < 16; ++r) x[nb][r] = 0.f;
            x[nb] = MFMA32(uf, bb[nb], x[nb]);
        }
#pragma unroll
        for (int pi = 0; pi < 2; ++pi) {
            f32x16& xr = x[pi]; f32x16& xi = x[2 + pi];
            const float a1r = A1r[pi], a1i = A1i[pi], a4r = A4r[pi], a4i = A4i[pi], a8r = A8r[pi], a8i = A8i[pi];
#pragma unroll
            for (int j = 0; j < 4; ++j) {
#pragma unroll
                for (int i = 1; i < 4; ++i) {
                    const float pr = xr[4 * j + i - 1], pim = xi[4 * j + i - 1];
                    xr[4 * j + i] += a1r * pr - a1i * pim;
                    xi[4 * j + i] += a1r * pim + a1i * pr;
                }
            }
            float Cr = cyr[pi], Ci = cyi[pi];
            float car[4], cai[4];
#pragma unroll
            for (int j = 0; j < 4; ++j) {
                const float er = xr[4 * j + 3], ei = xi[4 * j + 3];
                const float per = __shfl_xor(er, 32), pei = __shfl_xor(ei, 32);
                const float evr = h == 0 ? er : per, evi = h == 0 ? ei : pei;
                const float odr = h == 0 ? per : er, odi = h == 0 ? pei : ei;
                const float t4r = a4r * Cr - a4i * Ci + evr, t4i = a4r * Ci + a4i * Cr + evi;
                car[j] = h == 0 ? Cr : t4r; cai[j] = h == 0 ? Ci : t4i;
                const float Er = a4r * evr - a4i * evi + odr, Ei = a4r * evi + a4i * evr + odi;
                const float nr = a8r * Cr - a8i * Ci + Er, ni = a8r * Ci + a8i * Cr + Ei;
                Cr = nr; Ci = ni;
            }
            cyr[pi] = Cr; cyi[pi] = Ci;
            if (FULL) {
                const float pw_r[4] = {a1r, A2r[pi], A3r[pi], a4r}, pw_i[4] = {a1i, A2i[pi], A3i[pi], a4i};
#pragma unroll
                for (int j = 0; j < 4; ++j)
#pragma unroll
                    for (int i = 0; i < 4; ++i) {
                        const float hr = xr[4 * j + i] + pw_r[i] * car[j] - pw_i[i] * cai[j];
                        const float hi = xi[4 * j + i] + pw_r[i] * cai[j] + pw_i[i] * car[j];
                        const int trow = i + 8 * j + 4 * h;
                        *(LAS unsigned*)(Hl + trow * HL_STRIDE + p32 * 8 + pi * 4) = cvtpk_s(hr, hi);
                    }
            }
        }
        if (FULL) {
            const bf16* ZSdummy = nullptr; (void)ZSdummy;
            LAS unsigned char* Zl = lds + LDS_ZL;
            const int t16 = lane & 15, q4 = lane >> 4, ch = g * 16 + 4 * q4;
            const f32x4 dsk = *(const GAS f32x4*)(a->ssm_d + ch);
#pragma unroll
            for (int mt = 0; mt < 2; ++mt) {
                f32x4 ya = {0.f, 0.f, 0.f, 0.f};
#pragma unroll
                for (int ks = 0; ks < 4; ++ks) {
                    const bf16x8 hb = *(const LAS bf16x8*)(Hl + (16 * mt + t16) * HL_STRIDE + (32 * ks + 8 * q4) * 2);
                    ya = MFMA16(cmf[ks], hb, ya);
                }
                const int t = tb * 32 + 16 * mt + t16;
                const v2u uu = *(const GAS v2u*)(U + (size_t)(row0 + t) * 512 + ch);
                const float z0 = gelu_tanh_f(ya[0] + dsk[0] * bf_lo(uu.x)), z1 = gelu_tanh_f(ya[1] + dsk[1] * bf_hi(uu.x));
                const float z2 = gelu_tanh_f(ya[2] + dsk[2] * bf_lo(uu.y)), z3 = gelu_tanh_f(ya[3] + dsk[3] * bf_hi(uu.y));
                v2u w; w.x = pk2(z0, z1); w.y = pk2(z2, z3);
                *(LAS v2u*)(Zl + t * ZL_STRIDE + ch * 2) = w;
            }
        }
    }
    if (!FULL) {
        if (h == 0) {
            float* S = (float*)(ws + WS_SLOC) + (size_t)(cr * 32 + g) * 128;
#pragma unroll
            for (int pi = 0; pi < 2; ++pi) { S[pi * 32 + p32] = cyr[pi]; S[64 + pi * 32 + p32] = cyi[pi]; }
        }
    } else {
        const bool smp = cr >= 256;
        if ((smp || (cr & 31) == 31) && h == 0) {
            const int b = smp ? cr - 256 : cr >> 5;
            float* sr = a->out + (smp ? OFF_SRS : OFF_SRP) + (size_t)(b * 32 + g) * 64;
            float* si = a->out + (smp ? OFF_SIS : OFF_SIP) + (size_t)(b * 32 + g) * 64;
#pragma unroll
            for (int pi = 0; pi < 2; ++pi) { sr[pi * 32 + p32] = cyr[pi]; si[pi * 32 + p32] = cyi[pi]; }
        }
    }
}

__device__ __forceinline__ void ssm_local_unit(AP a, LAS unsigned char* lds, int cr, int wave, int lane) {
    for (int gi = 0; gi < 4; ++gi) ssm_group<false>(a, lds, cr, wave * 4 + gi, wave, lane);
}

__device__ __forceinline__ void ssm_full_unit(AP a, LAS unsigned char* lds, int cr, int tid, int wave, int lane) {
    asm volatile("" : "+v"(tid), "+v"(lane));
    unsigned char* ws = a->ws;
    const bool smp = cr >= 256; const int c = cr & 31, b = smp ? cr - 256 : cr >> 5, row0 = cr * 64;
    LAS float* Hp = (LAS float*)(lds + LDS_HP);
    const float* apow = (const float*)(ws + WS_APOW);
    const float* Sl = (const float*)(ws + WS_SLOC);
#pragma unroll
    for (int i = 0; i < 4; ++i) {
        const int ci = tid + 512 * i, g = ci >> 6, p = ci & 63;
        float hr = 0.f, hi = 0.f;
        if (smp) { hr = a->st_re[(size_t)(b * 32 + g) * 64 + p]; hi = a->st_im[(size_t)(b * 32 + g) * 64 + p]; }
        else {
            const float ar = apow[(size_t)ci * 12 + 10], ai = apow[(size_t)ci * 12 + 11];
            for (int j = 0; j < c; ++j) {
                const float* S = Sl + (size_t)((b * 32 + j) * 32 + g) * 128;
                const float sr = S[p], si = S[64 + p];
                const float nr = ar * hr - ai * hi + sr, ni = ar * hi + ai * hr + si;
                hr = nr; hi = ni;
            }
        }
        Hp[g * 128 + p] = hr; Hp[g * 128 + 64 + p] = hi;
    }
    __syncthreads();
    for (int gi = 0; gi < 4; ++gi) ssm_group<true>(a, lds, cr, wave * 4 + gi, wave, lane);
    __syncthreads();
    {
        const bf16* Wg = (const bf16*)(ws + WS_WGLU); const bf16* ZS = (const bf16*)(ws + WS_ZS); bf16* S1 = (bf16*)(ws + WS_AST) + (size_t)M * 512;
        LAS unsigned char* Zl = lds + LDS_ZL;
        asm volatile("" : "+v"(lane));
        const int t16 = lane & 15, q4 = lane >> 4;
        f32x4 acc[4][4];
#pragma unroll
        for (int nt = 0; nt < 4; ++nt)
#pragma unroll
            for (int mt = 0; mt < 4; ++mt) acc[nt][mt] = (f32x4){0.f, 0.f, 0.f, 0.f};
#pragma unroll 4
        for (int ks = 0; ks < 16; ++ks) {
            bf16x8 af[4], zf[4];
#pragma unroll
            for (int nt = 0; nt < 4; ++nt) af[nt] = *(const GAS bf16x8*)(Wg + (size_t)(64 * wave + 16 * nt + t16) * 512 + 32 * ks + 8 * q4);
#pragma unroll
            for (int mt = 0; mt < 4; ++mt) zf[mt] = *(const LAS bf16x8*)(Zl + (16 * mt + t16) * ZL_STRIDE + (32 * ks + 8 * q4) * 2);
#pragma unroll
            for (int nt = 0; nt < 4; ++nt)
#pragma unroll
                for (int mt = 0; mt < 4; ++mt) acc[nt][mt] = MFMA16(af[nt], zf[mt], acc[nt][mt]);
        }
#pragma unroll
        for (int nt = 0; nt < 4; ++nt)
#pragma unroll
            for (int mt = 0; mt < 4; ++mt) {
                const int n0 = 64 * wave + 16 * nt + 4 * q4, t = 16 * mt + t16;
                const v2u z = *(const LAS v2u*)(Zl + t * ZL_STRIDE + n0 * 2);
                const v2u zs = *(const GAS v2u*)(ZS + (size_t)(row0 + t) * 512 + n0);
                const f32x4 gt = acc[nt][mt];
                v2u w;
                w.x = pk2(bf_lo(z.x) * sigmoid_f(gt[0]) * bf_lo(zs.x), bf_hi(z.x) * sigmoid_f(gt[1]) * bf_hi(zs.x));
                w.y = pk2(bf_lo(z.y) * sigmoid_f(gt[2]) * bf_lo(zs.y), bf_hi(z.y) * sigmoid_f(gt[3]) * bf_hi(zs.y));
                *(GAS v2u*)(S1 + (size_t)(row0 + t) * 512 + n0) = w;
            }
    }
    __syncthreads();
}

__device__ __forceinline__ void final_norm_row(AP a, int m, int lane) {
    GAS f32x4* yr = (GAS f32x4*)(a->out + (size_t)m * DM) + lane; const GAS f32x4* gr = (const GAS f32x4*)a->fgain + lane;
    const float* sq = (const float*)(a->ws + WS_SSQ) + (size_t)m * 16;
    const f32x4 s0 = *(const GAS f32x4*)sq, s1 = *(const GAS f32x4*)(sq + 4), s2 = *(const GAS f32x4*)(sq + 8), s3 = *(const GAS f32x4*)(sq + 12);
    const float ss = ((s0[0] + s0[1]) + (s0[2] + s0[3])) + ((s1[0] + s1[1]) + (s1[2] + s1[3])) + ((s2[0] + s2[1]) + (s2[2] + s2[3])) + ((s3[0] + s3[1]) + (s3[2] + s3[3]));
    const float r = 1.f / sqrtf(ss * (1.f / DM) + EPS);
#pragma unroll
    for (int j = 0; j < 4; ++j) { const f32x4 v = yr[64 * j], g = gr[64 * j]; yr[64 * j] = v * r * g; }
}

__global__ void __launch_bounds__(NWAVES * 64, 2) mega_fwd(Args args) {
    extern __shared__ __attribute__((aligned(16))) unsigned char lds_raw[];
    LAS unsigned char* lds = (LAS unsigned char*)lds_raw;
    volatile LAS unsigned* MISC = (volatile LAS unsigned*)(lds + MISC_OFF);
    const int tid = threadIdx.x, lane = tid & 63, wave = __builtin_amdgcn_readfirstlane(tid >> 6);
    const int G = gridDim.x, bx = blockIdx.x;
    gu32* ctl; { AP ap = args_ptr(); ctl = (gu32*)(ap->ws + WS_CTL); }
    for (int u = tid; u < (LDS_BYTES - MISC_OFF) / 4; u += NWAVES * 64) ((LAS unsigned*)(lds + MISC_OFF))[u] = 0u;
    __syncthreads();
    XcdBarrier bar; bar.bar = (unsigned*)(ctl + CW_BAR); bar.x = 0; bar.st = nullptr;
    if (N_LAUNCHES == 1) bar = xcd_barrier_post((unsigned*)(ctl + CW_BAR), MISC + 8);
#define GRID_BAR() do { if (N_LAUNCHES == 1) xcd_barrier(bar); } while (0)
    int lo, hi; { AP ap = args_ptr(); lo = ap->ph_lo; hi = ap->ph_hi; }
#define IN(k) (lo <= (k) && (k) < hi)
#define BOTH(k) (IN(k) && IN((k) + 1))

    if (IN(0)) { p0_prologue(args_ptr(), lds, wave, lane); if (BOTH(0)) GRID_BAR(); }

    if (IN(1)) {
        AP ap = args_ptr(); unsigned char* ws = ap->ws;
        pg8::Gemm g{(const pg8::bf16_t*)(ws + WS_XN), (const pg8::bf16_t*)(ws + WS_WIN), M, INW, DM};
        pg8::StaticOrder S; S.init(M, INW, G, bx);
        pg8::EpiIn E{ws, ap->out};
        pg8::gemm_phase<pg8::EpiIn, pg8::StaticOrder, true, true>(lds, g, S, E);
        if (BOTH(1)) GRID_BAR();
    }

    if (IN(2)) {
        AP ap = args_ptr();
        for (int u = bx; u < 528; u += G) attn_unit(ap, lds, u, tid, wave, lane);
        for (int cr = bx; cr < 256; cr += G) ssm_local_unit(ap, lds, cr, wave, lane);
        if (BOTH(2)) GRID_BAR();
    }

    if (IN(3)) {
        AP ap = args_ptr();
        for (int cr = bx; cr < 264; cr += G) ssm_full_unit(ap, lds, cr, tid, wave, lane);
        if (BOTH(3)) GRID_BAR();
    }

    if (IN(4)) {
        AP ap = args_ptr(); unsigned char* ws = ap->ws;
        pg8::Gemm g{(const pg8::bf16_t*)(ws + WS_AST), (const pg8::bf16_t*)(ws + WS_WST), 2 * M, 2048, 512};
        pg8::PairOrder S; S.base.init(M, DM, G, bx); S.dM = M / 256; S.dN = 4;
        pg8::EpiMerge E{ws};
        pg8::gemm_phase<pg8::EpiMerge, pg8::PairOrder, true, true>(lds, g, S, E);
        if (BOTH(4)) GRID_BAR();
    }

    if (IN(5)) {
        AP ap = args_ptr(); unsigned char* ws = ap->ws;
        pg8::Gemm g{(const pg8::bf16_t*)(ws + WS_XN), (const pg8::bf16_t*)(ws + WS_WOUT), M, DM, DM};
        pg8::StaticOrder S; S.init(M, DM, G, bx);
        pg8::EpiH1 E{ap->x_prompt, ap->x_sample, ap->out, ws};
        pg8::gemm_phase<pg8::EpiH1, pg8::StaticOrder, true, true>(lds, g, S, E);
        if (BOTH(5)) GRID_BAR();
    }

    if (IN(6)) {
        AP ap = args_ptr(); unsigned char* ws = ap->ws;
        {
            pg8::Gemm g{(const pg8::bf16_t*)(ws + WS_P), (const pg8::bf16_t*)(ws + WS_WPP), M, DM, PLE};
            pg8::StaticOrder S; S.init(M, DM, G, bx);
            pg8::EpiPP E{ws};
            pg8::gemm_phase<pg8::EpiPP, pg8::StaticOrder, true, true>(lds, g, S, E);
        }
        {
            pg8::Gemm g{(const pg8::bf16_t*)(ws + WS_GA), (const pg8::bf16_t*)(ws + WS_WPG), M, DM, DM};
            pg8::StaticOrder S; S.init(M, DM, G, bx);
            pg8::EpiH2 E{ap->out, ws};
            pg8::gemm_phase<pg8::EpiH2, pg8::StaticOrder, true, true>(lds, g, S, E);
        }
        if (BOTH(6)) GRID_BAR();
    }

    if (IN(7)) {
        const int gw = bx * NWAVES + wave, NGW = G * NWAVES;
        AP ap = args_ptr();
        for (int m = gw; m < M; m += NGW) final_norm_row(ap, m, lane);
    }
#undef IN
#undef BOTH
}

extern "C" void kernel_launch(void* const* d_in, const int* in_sizes, int n_in, void* d_out, int out_size, void* d_ws, size_t ws_size, hipStream_t stream) {
    static int grid = 0;
    if (grid == 0) {
        if (n_in != 26 || (size_t)out_size != OUT_TOTAL || ws_size < WS_END) { fprintf(stderr, "kernel_launch: unexpected shapes (n_in %d, out %d, ws %zu); nothing launched\n", n_in, out_size, ws_size); grid = -1; return; }
        int dev = 0, cus = 0, per_cu = 0;
        if (hipGetDevice(&dev) != hipSuccess || hipDeviceGetAttribute(&cus, hipDeviceAttributeMultiprocessorCount, dev) != hipSuccess) { grid = -1; return; }
        if (hipFuncSetAttribute((const void*)mega_fwd, hipFuncAttributeMaxDynamicSharedMemorySize, LDS_BYTES) != hipSuccess) { fprintf(stderr, "kernel_launch: hipFuncSetAttribute failed\n"); grid = -1; return; }
        if (hipOccupancyMaxActiveBlocksPerMultiprocessor(&per_cu, (const void*)mega_fwd, NWAVES * 64, LDS_BYTES) != hipSuccess || per_cu < 1) { fprintf(stderr, "kernel_launch: occupancy query says %d blocks per CU\n", per_cu); per_cu = 1; }
        (void)hipGetLastError();
        grid = cus;
    }
    if (grid < 0) return;
    if (hipMemsetAsync((char*)d_ws + WS_CTL, 0, CTL_ZERO_BYTES, stream) != hipSuccess) { fprintf(stderr, "kernel_launch: memset failed\n"); return; }
    Args a{};
    const float** pa = (const float**)&a;
    for (int i = 0; i < 26; ++i) pa[i] = (const float*)d_in[i];
    a.out = (float*)d_out; a.ws = (unsigned char*)d_ws;
    for (int li = 0; li < N_LAUNCHES; ++li) {
        a.ph_lo = (N_LAUNCHES == 1) ? 0 : li; a.ph_hi = (N_LAUNCHES == 1) ? N_PHASES : li + 1;
        hipLaunchKernelGGL(mega_fwd, dim3(grid), dim3(NWAVES * 64), LDS_BYTES, stream, a);
        const hipError_t le = hipPeekAtLastError();
        if (le != hipSuccess) { fprintf(stderr, "kernel_launch: launch %d failed: %s\n", li, hipGetErrorName(le)); break; }
    }
}
```

```cpp
#include <hip/hip_runtime.h>
#include <cstdio>
#include <cstdint>

typedef float f32x2_t __attribute__((ext_vector_type(2)));
typedef __bf16 bf16x2_t __attribute__((ext_vector_type(2)));
__device__ __forceinline__ unsigned cvtpk_s(float lo, float hi) { f32x2_t v = {lo, hi}; bf16x2_t b = __builtin_convertvector(v, bf16x2_t); return __builtin_bit_cast(unsigned, b); }
__device__ __forceinline__ float bf_lo(unsigned w) { return __uint_as_float(w << 16); }
__device__ __forceinline__ float bf_hi(unsigned w) { return __uint_as_float(w & 0xffff0000u); }
__device__ __forceinline__ float fast_exp(float x) { return __builtin_amdgcn_exp2f(x * 1.4426950408889634f); }
__device__ __forceinline__ float sigmoid_f(float x) { return __builtin_amdgcn_rcpf(1.0f + fast_exp(-x)); }
__device__ __forceinline__ float silu_f(float x) { return x * sigmoid_f(x); }
__device__ __forceinline__ float gelu_tanh_f(float x) { const float u = 1.5957691216057308f * (x + 0.044715f * x * x * x); return x * sigmoid_f(u); }

constexpr int DM = 1024, SEQ = 2048, NB = 8, DSEQ = 64, MP = NB * SEQ  , MS = NB * DSEQ  , M = MP + MS  ;
constexpr int INW = 4352, PLE = 256, PAST = 1024;
constexpr float EPS = 1e-6f;
constexpr size_t OFF_Y = 0, OFF_KP = (size_t)M * DM, OFF_VP = OFF_KP + 131072, OFF_SRP = OFF_VP + 131072, OFF_SIP = OFF_SRP + 16384,
                 OFF_KS = OFF_SIP + 16384, OFF_VS = OFF_KS + 131072, OFF_SRS = OFF_VS + 131072, OFF_SIS = OFF_SRS + 16384, OUT_TOTAL = OFF_SIS + 16384;

constexpr size_t MiB = 1u << 20;
constexpr size_t WS_CTL = 0, CTL_ZERO_BYTES = 1 * MiB;
constexpr size_t WS_WIN = 2 * MiB;
constexpr size_t WS_WST = 11 * MiB;
constexpr size_t WS_WGLU = 13 * MiB;
constexpr size_t WS_WOUT = 14 * MiB;
constexpr size_t WS_WPG = 16 * MiB;
constexpr size_t WS_WPP = 18 * MiB;
constexpr size_t WS_ROPE = 19 * MiB;
constexpr size_t WS_SSMB = 19 * MiB + 256 * 1024;
constexpr size_t WS_SSMC = 19 * MiB + 512 * 1024;
constexpr size_t WS_APOW = 19 * MiB + 768 * 1024;
constexpr size_t WS_SLOC = 20 * MiB;
constexpr size_t WS_SSQ = 24 * MiB;
constexpr size_t WS_XN = 32 * MiB;
constexpr size_t WS_P = 66 * MiB;
constexpr size_t WS_Q = 75 * MiB;
constexpr size_t WS_K = 92 * MiB;
constexpr size_t WS_V = 97 * MiB;
constexpr size_t WS_ZA = 102 * MiB;
constexpr size_t WS_U = 119 * MiB;
constexpr size_t WS_ZS = 136 * MiB;
constexpr size_t WS_GA = 153 * MiB;
constexpr size_t WS_GS = 186 * MiB;
constexpr size_t WS_AST = 219 * MiB;
constexpr size_t WS_END = 252 * MiB;
static_assert(WS_XN + (size_t)M * 1024 * 2 <= WS_P && WS_P + (size_t)M * 256 * 2 <= WS_Q && WS_Q + (size_t)M * 512 * 2 <= WS_K && WS_K + (size_t)M * 128 * 2 <= WS_V && WS_V + (size_t)M * 128 * 2 <= WS_ZA &&
              WS_ZA + (size_t)M * 512 * 2 <= WS_U && WS_U + (size_t)M * 512 * 2 <= WS_ZS && WS_ZS + (size_t)M * 512 * 2 <= WS_GA && WS_GA + (size_t)M * 1024 * 2 <= WS_GS && WS_GS + (size_t)M * 1024 * 2 <= WS_AST &&
              WS_AST + (size_t)2 * M * 512 * 2 <= WS_END && WS_WIN + (size_t)INW * 1024 * 2 <= WS_WST && WS_SSQ + (size_t)M * 16 * 4 <= WS_XN, "d_ws map");
constexpr int CW_TMO = 0, CW_BAR = 4096;

namespace pg8 {
#define PG8_LAS __attribute__((address_space(3)))
typedef unsigned short bf16_t;
typedef short bf16x8 __attribute__((ext_vector_type(8)));
typedef float f32x4 __attribute__((ext_vector_type(4)));
typedef unsigned u32x4 __attribute__((ext_vector_type(4)));
constexpr int BM = 256, BK = 64, HALF = 128, HTB = HALF * BK * 2  , STAGE_BYTES = 8 * HTB, NXCD = 8, WGM = 8;

__host__ __device__ __forceinline__ int lds_byte(int r, int c) { const int st = (r >> 4) * 2 + (c >> 5), rr = r & 15, cc = c & 31, ob = rr * 64 + cc * 2; return st * 1024 + (ob ^ (((ob >> 9) & 1) << 5)); }
__host__ __device__ __forceinline__ void stage_rc(int b, int& R, int& C) { const int st = b / 1024, sb = b % 1024, swz = sb ^ (((sb >> 9) & 1) << 5); R = (st >> 1) * 16 + swz / 64; C = (st & 1) * 32 + (swz % 64) / 2; }
__host__ __device__ __forceinline__ int perm32(int rho) { const int n = rho >> 4, i = rho & 15; return 8 * (i >> 2) + 4 * n + (i & 3); }

struct Unit { int pm, pn; };
struct Gemm { const bf16_t* A; const bf16_t* Bt; int M, N, K; };

struct StaticOrder {
    int nM, nN, nwg, G, c;
    __host__ __device__ void init(int M, int N, int G_, int c_) { nM = M / BM; nN = N / BM; nwg = nM * nN; G = G_; c = c_; }
    __host__ __device__ bool next(int i, Unit& u) const {
        const long L = (long)i * G + c; if (L >= nwg) return false;
        int wgid = (int)L; { const int q = nwg / NXCD, r = nwg % NXCD, xcd = wgid % NXCD, off = wgid / NXCD; wgid = (xcd < r ? xcd * (q + 1) : r * (q + 1) + (xcd - r) * q) + off; }
        const int nig = WGM * nN, gid = wgid / nig, fm = gid * WGM, gsz = (nM - fm) < WGM ? (nM - fm) : WGM;
        u.pm = fm + ((wgid % nig) % gsz); u.pn = (wgid % nig) / gsz; return true;
    }
    __device__ __forceinline__ void a_ready(const Unit&) const {}
    __device__ __forceinline__ void done(const Unit&) const {}
};


struct PairOrder {
    StaticOrder base; int dM, dN;
    __host__ __device__ bool next(int i, Unit& u) const { if (!base.next(i >> 1, u)) return false; if (i & 1) { u.pm += dM; u.pn += dN; } return true; }
    __device__ __forceinline__ void a_ready(const Unit&) const {}
    __device__ __forceinline__ void done(const Unit&) const {}
};

__device__ __forceinline__ u32x4 pack8(const f32x4 a, const f32x4 b) { u32x4 w; w.x = cvtpk_s(a[0], a[1]); w.y = cvtpk_s(a[2], a[3]); w.z = cvtpk_s(b[0], b[1]); w.w = cvtpk_s(b[2], b[3]); return w; }
__device__ __forceinline__ void unpack8(const u32x4 w, f32x4& a, f32x4& b) { a[0] = bf_lo(w.x); a[1] = bf_hi(w.x); a[2] = bf_lo(w.y); a[3] = bf_hi(w.y); b[0] = bf_lo(w.z); b[1] = bf_hi(w.z); b[2] = bf_lo(w.w); b[3] = bf_hi(w.w); }

struct EpiIn {
    static constexpr bool PERM = true, AFTER_DRAIN = false, CHAIN = false;
    unsigned char* ws; float* out;
    __device__ __forceinline__ void operator()(f32x4 (&acc)[2][2][4][2], const Unit& u, int wr, int wc, int fr, int fq) const {
        bf16_t* const Q = (bf16_t*)(ws + WS_Q); bf16_t* const Kb = (bf16_t*)(ws + WS_K); bf16_t* const Vb = (bf16_t*)(ws + WS_V); bf16_t* const ZA = (bf16_t*)(ws + WS_ZA);
        bf16_t* const U = (bf16_t*)(ws + WS_U); bf16_t* const ZS = (bf16_t*)(ws + WS_ZS); bf16_t* const GA = (bf16_t*)(ws + WS_GA); bf16_t* const GS = (bf16_t*)(ws + WS_GS);
        const float* const rope = (const float*)(ws + WS_ROPE);
        const int pn = u.pn;
        const int rowb = u.pm * BM + wr * 64 + fr;
        const int cw = wc * 32 + 8 * fq;
        bf16_t* dst; int ld, cbase, mode;
        if (pn < 2)       { dst = Q;  ld = 512;  cbase = pn * 256;        mode = 3; }
        else if (pn == 2) { dst = Kb; ld = 128;  cbase = 0;               mode = 4; }
        else if (pn < 5)  { dst = ZA; ld = 512;  cbase = (pn - 3) * 256;  mode = 1; }
        else if (pn < 7)  { dst = U;  ld = 512;  cbase = (pn - 5) * 256;  mode = 0; }
        else if (pn < 9)  { dst = ZS; ld = 512;  cbase = (pn - 7) * 256;  mode = 1; }
        else if (pn < 13) { dst = GA; ld = 1024; cbase = (pn - 9) * 256;  mode = 2; }
        else              { dst = GS; ld = 1024; cbase = (pn - 13) * 256; mode = 2; }
        const bool ropew = ((wc & 1) == 0);
#pragma unroll
        for (int ai = 0; ai < 2; ++ai)
#pragma unroll
            for (int m = 0; m < 4; ++m) {
                const int row = rowb + ai * HALF + m * 16;
                const int pos = row < MP ? (row & (SEQ - 1)) : PAST + ((row - MP) & (DSEQ - 1));
#pragma unroll
                for (int bj = 0; bj < 2; ++bj) {
                    f32x4 v0 = acc[ai][bj][m][0], v1 = acc[ai][bj][m][1];
                    if (mode == 1) {
#pragma unroll
                        for (int j = 0; j < 4; ++j) { v0[j] = silu_f(v0[j]); v1[j] = silu_f(v1[j]); }
                    } else if (mode == 2) {
#pragma unroll
                        for (int j = 0; j < 4; ++j) { v0[j] = sigmoid_f(v0[j]); v1[j] = sigmoid_f(v1[j]); }
                    } else if (mode == 3 || (mode == 4 && bj == 0)) {
                        if (ropew) {
                            f32x4 p0, p1;
#pragma unroll
                            for (int j = 0; j < 4; ++j) { p0[j] = __shfl_xor(v0[j], 16); p1[j] = __shfl_xor(v1[j], 16); }
                            if (fq < 2) {
                                const f32x4* cs = (const f32x4*)(rope + (size_t)pos * 16);
                                const f32x4 c01 = cs[0], c23 = cs[1], c45 = cs[2], c67 = cs[3];
                                const float sg = fq == 0 ? -1.f : 1.f;
                                v0[0] = v0[0] * c01[0] + sg * p0[0] * c01[1]; v0[1] = v0[1] * c01[2] + sg * p0[1] * c01[3];
                                v0[2] = v0[2] * c23[0] + sg * p0[2] * c23[1]; v0[3] = v0[3] * c23[2] + sg * p0[3] * c23[3];
                                v1[0] = v1[0] * c45[0] + sg * p1[0] * c45[1]; v1[1] = v1[1] * c45[2] + sg * p1[1] * c45[3];
                                v1[2] = v1[2] * c67[0] + sg * p1[2] * c67[1]; v1[3] = v1[3] * c67[2] + sg * p1[3] * c67[3];
                            }
                        }
                    }
                    if (mode == 4) {
                        bf16_t* d2 = bj == 0 ? Kb : Vb;
                        *(u32x4*)(d2 + (size_t)row * 128 + cw) = pack8(v0, v1);
                        float* w = nullptr;
                        if (u.pm >= MP / BM) { const int rs = row - MP; w = out + (bj == 0 ? OFF_KS : OFF_VS) + ((size_t)((rs >> 6) * 128 + 64 + (rs & 63))) * 128 + cw; }
                        else if ((u.pm & 7) == 7 && ai == 1) { const int t = row & (SEQ - 1); w = out + (bj == 0 ? OFF_KP : OFF_VP) + ((size_t)((row >> 11) * 128 + (t - (SEQ - 128)))) * 128 + cw; }
                        if (w) { *(f32x4*)w = v0; *(f32x4*)(w + 4) = v1; }
                    } else {
                        *(u32x4*)(dst + (size_t)row * ld + cbase + bj * HALF + cw) = pack8(v0, v1);
                    }
                }
            }
    }
};

struct EpiMerge {
    static constexpr bool PERM = true, AFTER_DRAIN = false, CHAIN = true;
    unsigned char* ws;
    static constexpr int nMt = M / BM;
    __device__ __forceinline__ void operator()(f32x4 (&acc)[2][2][4][2], const Unit& u, int wr, int wc, int fr, int fq) const {
        const bf16_t* const GA = (const bf16_t*)(ws + WS_GA); const bf16_t* const GS = (const bf16_t*)(ws + WS_GS); bf16_t* const MG = (bf16_t*)(ws + WS_XN);
        const bool second = u.pn >= 4;
        const int pm = second ? u.pm - nMt : u.pm, pn = second ? u.pn - 4 : u.pn;
        const int rowb = pm * BM + wr * 64 + fr, colb = pn * BM + wc * 32 + 8 * fq;
#pragma unroll
        for (int ai = 0; ai < 2; ++ai)
#pragma unroll
            for (int m = 0; m < 4; ++m) {
                const size_t ro = (size_t)(rowb + ai * HALF + m * 16) * DM + colb;
#pragma unroll
                for (int bj = 0; bj < 2; ++bj) {
                    f32x4 s0, s1; unpack8(*(const u32x4*)(GS + ro + bj * HALF), s0, s1);
                    if (!second) {
                        f32x4 a0, a1; unpack8(*(const u32x4*)(GA + ro + bj * HALF), a0, a1);
#pragma unroll
                        for (int j = 0; j < 4; ++j) { acc[ai][bj][m][0][j] *= a0[j] * __builtin_amdgcn_rcpf(s0[j]); acc[ai][bj][m][1][j] *= a1[j] * __builtin_amdgcn_rcpf(s1[j]); }
                    } else {
                        *(u32x4*)(MG + ro + bj * HALF) = pack8(acc[ai][bj][m][0] * s0, acc[ai][bj][m][1] * s1);
                    }
                }
                asm volatile("" ::: "memory");
            }
    }
};

struct EpiH1 {
    static constexpr bool PERM = true, AFTER_DRAIN = false, CHAIN = false;
    const float *xp, *xs; float* out; unsigned char* ws;
    __device__ __forceinline__ void operator()(f32x4 (&acc)[2][2][4][2], const Unit& u, int wr, int wc, int fr, int fq) const {
        bf16_t* const H1B = (bf16_t*)(ws + WS_GA);
        const int rowb = u.pm * BM + wr * 64 + fr, colb = u.pn * BM + wc * 32 + 8 * fq;
        const float* xb = u.pm < MP / BM ? xp : xs - (size_t)MP * DM;
#pragma unroll
        for (int ai = 0; ai < 2; ++ai)
#pragma unroll
            for (int m = 0; m < 4; ++m) {
                const size_t ro = (size_t)(rowb + ai * HALF + m * 16) * DM + colb;
#pragma unroll
                for (int bj = 0; bj < 2; ++bj) {
                    const f32x4 h0 = *(const f32x4*)(xb + ro + bj * HALF) + acc[ai][bj][m][0], h1 = *(const f32x4*)(xb + ro + bj * HALF + 4) + acc[ai][bj][m][1];
                    *(f32x4*)(out + ro + bj * HALF) = h0; *(f32x4*)(out + ro + bj * HALF + 4) = h1;
                    *(u32x4*)(H1B + ro + bj * HALF) = pack8(h0, h1);
                }
                asm volatile("" ::: "memory");
            }
    }
};

struct EpiPP {
    static constexpr bool PERM = true, AFTER_DRAIN = false, CHAIN = false;
    unsigned char* ws;
    __device__ __forceinline__ void operator()(f32x4 (&acc)[2][2][4][2], const Unit& u, int wr, int wc, int fr, int fq) const {
        bf16_t* const PP = (bf16_t*)(ws + WS_GS);
        const int rowb = u.pm * BM + wr * 64 + fr, colb = u.pn * BM + wc * 32 + 8 * fq;
#pragma unroll
        for (int ai = 0; ai < 2; ++ai)
#pragma unroll
            for (int m = 0; m < 4; ++m) {
                const size_t ro = (size_t)(rowb + ai * HALF + m * 16) * DM + colb;
#pragma unroll
                for (int bj = 0; bj < 2; ++bj) *(u32x4*)(PP + ro + bj * HALF) = pack8(acc[ai][bj][m][0], acc[ai][bj][m][1]);
            }
    }
};

struct EpiH2 {
    static constexpr bool PERM = true, AFTER_DRAIN = false, CHAIN = false;
    float* out; unsigned char* ws;
    __device__ __forceinline__ void operator()(f32x4 (&acc)[2][2][4][2], const Unit& u, int wr, int wc, int fr, int fq) const {
        const bf16_t* const PP = (const bf16_t*)(ws + WS_GS); float* const ssq = (float*)(ws + WS_SSQ);
        const int rowb = u.pm * BM + wr * 64 + fr, colb = u.pn * BM + wc * 32 + 8 * fq;
#pragma unroll
        for (int ai = 0; ai < 2; ++ai)
#pragma unroll
            for (int m = 0; m < 4; ++m) {
                const int row = rowb + ai * HALF + m * 16;
                const size_t ro = (size_t)row * DM + colb;
                float sq = 0.f;
#pragma unroll
                for (int bj = 0; bj < 2; ++bj) {
                    f32x4 p0, p1; unpack8(*(const u32x4*)(PP + ro + bj * HALF), p0, p1);
                    f32x4 h0 = *(const f32x4*)(out + ro + bj * HALF), h1 = *(const f32x4*)(out + ro + bj * HALF + 4);
#pragma unroll
                    for (int j = 0; j < 4; ++j) { h0[j] += sigmoid_f(acc[ai][bj][m][0][j]) * p0[j]; h1[j] += sigmoid_f(acc[ai][bj][m][1][j]) * p1[j]; sq += h0[j] * h0[j] + h1[j] * h1[j]; }
                    *(f32x4*)(out + ro + bj * HALF) = h0; *(f32x4*)(out + ro + bj * HALF + 4) = h1;
                }
                sq += __shfl_xor(sq, 16); sq += __shfl_xor(sq, 32);
                if (fq == 0) ssq[(size_t)row * 16 + u.pn * 4 + wc] = sq;
                asm volatile("" ::: "memory");
            }
    }
};

template <class Epi, class Sched, bool ALIGN_EPI = false, bool SP2 = false>
__device__ __forceinline__ void gemm_phase(PG8_LAS unsigned char* lds, const Gemm g, const Sched& S, const Epi& E) {
    int tid = threadIdx.x; asm volatile("" : "+v"(tid));
    const int wid = __builtin_amdgcn_readfirstlane(tid >> 6), lane = tid & 63, wr = wid >> 2, wc = wid & 3, fr = lane & 15, fq = lane >> 4;
    int K = g.K; asm volatile("" : "+s"(K));
    const int nt = K / BK;
    unsigned voffA[2], voffB[2];
#pragma unroll
    for (int i = 0; i < 2; ++i) { int R, C; stage_rc(tid * 16 + i * 8192, R, C); const int Rb = Epi::PERM ? ((R & ~31) + perm32(R & 31)) : R;
        voffA[i] = (unsigned)(R * K + C) * 2u; voffB[i] = (unsigned)(Rb * K + C) * 2u; }
    const size_t kstep = (size_t)(BK * 2);
    const size_t hstep = (size_t)HALF * K * 2;
    const size_t tstep = 2 * hstep;
    const unsigned ldsw = (unsigned)wid * 1024u;
    const int aoff = lds_byte(wr * 64 + fr, fq * 8), boff = lds_byte(wc * 32 + fr, fq * 8);
#define PG8_SA(b, h) (((b) * 2 + (h)) * HTB)
#define PG8_SB(b, h) ((4 + (b) * 2 + (h)) * HTB)
#define PG8_STAGE(bufoff, gbase, voff) do { _Pragma("unroll") for (int _i = 0; _i < 2; ++_i) \
        __builtin_amdgcn_global_load_lds((const unsigned*)((const char*)(gbase) + (voff)[_i]), (PG8_LAS unsigned*)(lds + (bufoff) + ldsw + _i * 8192), 16, 0, 0); } while (0)
#define PG8_LDA(dst, b, h) do { _Pragma("unroll") for (int m = 0; m < 4; ++m) _Pragma("unroll") for (int k = 0; k < 2; ++k) dst[m][k] = *(const PG8_LAS bf16x8*)(lds + PG8_SA(b, h) + aoff + m * 2048 + k * 1024); } while (0)
#define PG8_LDB(dst, b, h) do { _Pragma("unroll") for (int n = 0; n < 2; ++n) _Pragma("unroll") for (int k = 0; k < 2; ++k) dst[n][k] = *(const PG8_LAS bf16x8*)(lds + PG8_SB(b, h) + boff + n * 2048 + k * 1024); } while (0)
#define PG8_MMA(ai, bj, At, Bt) do { __builtin_amdgcn_s_setprio(1); _Pragma("unroll") for (int m = 0; m < 4; ++m) _Pragma("unroll") for (int n = 0; n < 2; ++n) _Pragma("unroll") for (int k = 0; k < 2; ++k) \
        acc[ai][bj][m][n] = __builtin_amdgcn_mfma_f32_16x16x32_bf16(Bt[n][k], At[m][k], acc[ai][bj][m][n], 0, 0, 0); __builtin_amdgcn_s_setprio(0); } while (0)
#define PG8_WAIT_V(n) asm volatile("s_waitcnt vmcnt(" #n ")" ::: "memory")
#define PG8_WAIT_L(n) asm volatile("s_waitcnt lgkmcnt(" #n ")" ::: "memory")
#define PG8_BAR __builtin_amdgcn_s_barrier()
#define PG8_SCHED __builtin_amdgcn_sched_barrier(0)
    Unit cur, nxt; int ui = 0;
    if (!S.next(0, cur)) return;
    f32x4 acc[2][2][4][2];
#pragma unroll
    for (int a = 0; a < 2; ++a)
#pragma unroll
        for (int b = 0; b < 2; ++b)
#pragma unroll
            for (int m = 0; m < 4; ++m)
#pragma unroll
                for (int n = 0; n < 2; ++n) acc[a][b][m][n] = (f32x4){0.f, 0.f, 0.f, 0.f};
    bf16x8 At[4][2], B0[2][2], B1[2][2];
    const char* cA = (const char*)g.A + (size_t)cur.pm * tstep; const char* cB = (const char*)g.Bt + (size_t)cur.pn * tstep;
    S.a_ready(cur);
    if constexpr (SP2) {
        PG8_STAGE(PG8_SB(0, 0), cB, voffB); PG8_STAGE(PG8_SB(0, 1), cB + hstep, voffB); PG8_STAGE(PG8_SA(0, 0), cA, voffA); PG8_STAGE(PG8_SA(0, 1), cA + hstep, voffA);
        if (wr == 1) PG8_BAR;
        PG8_WAIT_V(2); PG8_BAR;
        PG8_STAGE(PG8_SB(1, 0), cB + kstep, voffB); PG8_STAGE(PG8_SA(1, 0), cA + kstep, voffA); PG8_STAGE(PG8_SB(1, 1), cB + hstep + kstep, voffB);
        PG8_WAIT_V(6); PG8_BAR;
    } else {
        PG8_STAGE(PG8_SB(0, 0), cB, voffB); PG8_STAGE(PG8_SA(0, 0), cA, voffA); PG8_STAGE(PG8_SB(0, 1), cB + hstep, voffB); PG8_STAGE(PG8_SA(0, 1), cA + hstep, voffA);
        if (wr == 1) PG8_BAR;
        PG8_WAIT_V(4); PG8_BAR;
        PG8_STAGE(PG8_SB(1, 0), cB + kstep, voffB); PG8_STAGE(PG8_SA(1, 0), cA + kstep, voffA); PG8_STAGE(PG8_SB(1, 1), cB + hstep + kstep, voffB);
        PG8_WAIT_V(6); PG8_BAR;
    }
    for (;;) {
        const bool has_next = S.next(ui + 1, nxt);
        const char* nA = has_next ? (const char*)g.A + (size_t)nxt.pm * tstep : cA; const char* nB = has_next ? (const char*)g.Bt + (size_t)nxt.pn * tstep : cB;
        for (int t = 0; t < nt; t += 2) {
            const bool last = (t == nt - 2);
            const char* a1 = cA + (size_t)(t + 1) * kstep;
            const char* a2 = last ? nA : cA + (size_t)(t + 2) * kstep; const char* b2 = last ? nB : cB + (size_t)(t + 2) * kstep;
            const char* a3 = a2 + kstep; const char* b3 = b2 + kstep;
            if (last && has_next) S.a_ready(nxt);
            if constexpr (SP2) {
            PG8_LDB(B0, 0, 0); PG8_LDB(B1, 0, 1); PG8_SCHED; PG8_LDA(At, 0, 0); PG8_STAGE(PG8_SA(1, 1), a1 + hstep, voffA);
            PG8_WAIT_V(8); PG8_WAIT_L(0); PG8_BAR; PG8_MMA(0, 0, At, B0); PG8_MMA(0, 1, At, B1); PG8_BAR; PG8_SCHED;
            PG8_LDA(At, 0, 1); PG8_STAGE(PG8_SB(0, 0), b2, voffB); PG8_STAGE(PG8_SB(0, 1), b2 + hstep, voffB); PG8_STAGE(PG8_SA(0, 0), a2, voffA);
            PG8_WAIT_V(8); PG8_WAIT_L(0); PG8_BAR; PG8_MMA(1, 0, At, B0); PG8_MMA(1, 1, At, B1); PG8_BAR; PG8_SCHED;
            PG8_LDB(B0, 1, 0); PG8_LDB(B1, 1, 1); PG8_SCHED; PG8_LDA(At, 1, 0); PG8_STAGE(PG8_SA(0, 1), a2 + hstep, voffA);
            PG8_WAIT_V(8); PG8_WAIT_L(0); PG8_BAR; PG8_MMA(0, 0, At, B0); PG8_MMA(0, 1, At, B1); PG8_BAR; PG8_SCHED;
            PG8_LDA(At, 1, 1); PG8_STAGE(PG8_SB(1, 0), b3, voffB); PG8_STAGE(PG8_SB(1, 1), b3 + hstep, voffB); PG8_STAGE(PG8_SA(1, 0), a3, voffA);
            PG8_WAIT_V(8); PG8_WAIT_L(0); PG8_BAR; PG8_MMA(1, 0, At, B0); PG8_MMA(1, 1, At, B1); PG8_BAR; PG8_SCHED;
            } else {
            PG8_LDB(B0, 0, 0); PG8_SCHED; PG8_LDA(At, 0, 0); PG8_STAGE(PG8_SA(1, 1), a1 + hstep, voffA);
            PG8_WAIT_L(8); PG8_BAR; PG8_WAIT_L(0); PG8_MMA(0, 0, At, B0); PG8_BAR; PG8_SCHED;
            PG8_LDB(B1, 0, 1); PG8_STAGE(PG8_SB(0, 0), b2, voffB);
            PG8_BAR; PG8_WAIT_L(0); PG8_MMA(0, 1, At, B1); PG8_BAR;
            PG8_LDA(At, 0, 1); PG8_STAGE(PG8_SA(0, 0), a2, voffA);
            PG8_BAR; PG8_WAIT_L(0); PG8_MMA(1, 0, At, B0); PG8_BAR; PG8_SCHED;
            PG8_STAGE(PG8_SB(0, 1), b2 + hstep, voffB);
            PG8_WAIT_V(6); PG8_BAR; PG8_MMA(1, 1, At, B1); PG8_BAR;
            PG8_LDB(B0, 1, 0); PG8_SCHED; PG8_LDA(At, 1, 0); PG8_STAGE(PG8_SA(0, 1), a2 + hstep, voffA);
            PG8_WAIT_L(8); PG8_BAR; PG8_WAIT_L(0); PG8_MMA(0, 0, At, B0); PG8_BAR; PG8_SCHED;
            PG8_LDB(B1, 1, 1); PG8_STAGE(PG8_SB(1, 0), b3, voffB);
            PG8_BAR; PG8_WAIT_L(0); PG8_MMA(0, 1, At, B1); PG8_BAR;
            PG8_LDA(At, 1, 1); PG8_STAGE(PG8_SA(1, 0), a3, voffA);
            PG8_BAR; PG8_WAIT_L(0); PG8_MMA(1, 0, At, B0); PG8_BAR; PG8_SCHED;
            PG8_STAGE(PG8_SB(1, 1), b3 + hstep, voffB);
            PG8_WAIT_V(6); PG8_BAR; PG8_MMA(1, 1, At, B1); PG8_BAR;
            }
        }
        if constexpr (ALIGN_EPI) { if (wr == 0) PG8_BAR; }
        if constexpr (!Epi::AFTER_DRAIN) { E(acc, cur, wr, wc, fr, fq); S.done(cur); }
        if (!has_next) break;
        if (!(Epi::CHAIN && (ui & 1) == 0)) {
#pragma unroll
        for (int a = 0; a < 2; ++a)
#pragma unroll
            for (int b = 0; b < 2; ++b)
#pragma unroll
                for (int m = 0; m < 4; ++m)
#pragma unroll
                    for (int n = 0; n < 2; ++n) acc[a][b][m][n] = (f32x4){0.f, 0.f, 0.f, 0.f};
        }
        cur = nxt; cA = nA; cB = nB; ++ui;
        if constexpr (ALIGN_EPI) { if (wr == 1) PG8_BAR; }
    }
    PG8_WAIT_V(0);
    if constexpr (!ALIGN_EPI) { if (wr == 0) PG8_BAR; }
    PG8_BAR;
    if constexpr (Epi::AFTER_DRAIN) { E.fused(acc, cur, wr, wc, fr, fq, lds, wid, lane); S.done(cur); }
#undef PG8_SA
#undef PG8_SB
#undef PG8_STAGE
#undef PG8_LDA
#undef PG8_LDB
#undef PG8_MMA
#undef PG8_WAIT_V
#undef PG8_WAIT_L
#undef PG8_BAR
#undef PG8_SCHED
}
}


constexpr int NWAVES = 8;
#ifndef MK_N_LAUNCHES
#define MK_N_LAUNCHES 1
#endif
constexpr int N_PHASES = 8;
constexpr int N_LAUNCHES = MK_N_LAUNCHES;

constexpr int RING_BYTES = 131072;
constexpr int KL_STRIDE = 144, VT_STRIDE = 400;
constexpr int LDS_KL = 0, LDS_VT = 192 * KL_STRIDE;
constexpr int ZL_STRIDE = 1040, HL_STRIDE = 272;
constexpr int LDS_ZL = 0, LDS_HL = 64 * ZL_STRIDE  , HL_WAVE = 32 * HL_STRIDE  , LDS_HP = LDS_HL + NWAVES * HL_WAVE  , LDS_P3_END = LDS_HP + 16384  ;
constexpr int MISC_OFF = LDS_P3_END;
constexpr int LDS_BYTES = 153600;
static_assert(MISC_OFF + 512 <= LDS_BYTES && LDS_VT + 64 * VT_STRIDE <= RING_BYTES, "LDS map");

#define GAS __attribute__((address_space(1)))
#define LAS __attribute__((address_space(3)))
typedef unsigned short bf16;
typedef unsigned v4u __attribute__((ext_vector_type(4)));
typedef unsigned v2u __attribute__((ext_vector_type(2)));
typedef float f32x4 __attribute__((ext_vector_type(4)));
typedef float f32x16 __attribute__((ext_vector_type(16)));
typedef short bf16x8 __attribute__((ext_vector_type(8)));
typedef GAS unsigned gu32;
#define RLX_AGENT __ATOMIC_RELAXED, __HIP_MEMORY_SCOPE_AGENT
#define LDS_WAIT() asm volatile("s_waitcnt lgkmcnt(0)" ::: "memory")
#define VM_WAIT() asm volatile("s_waitcnt vmcnt(0)" ::: "memory")
__device__ __forceinline__ unsigned pk2(float lo, float hi) { return cvtpk_s(lo, hi); }
__device__ __forceinline__ bf16 f2bf(float f) { return (bf16)(cvtpk_s(f, 0.f) & 0xffffu); }

#define XB_TMO      128
#define XB_XCNT(j)  (256  + 64 * (j))
#define XB_XSUB(j)  (1280 + 64 * (j))
#define XB_XGEN(j)  (2304 + 64 * (j))
#define XB_TOP      3328
#define XB_TOPGEN   3392
#define XCD_BAR_WORDS 3456
#define XB_SPIN_CAP (1u << 18)

__device__ __forceinline__ unsigned xb_ld(unsigned* p)              { return __hip_atomic_load(p, __ATOMIC_RELAXED, __HIP_MEMORY_SCOPE_AGENT); }
__device__ __forceinline__ unsigned xb_add(unsigned* p, unsigned v) { return __hip_atomic_fetch_add(p, v, __ATOMIC_RELAXED, __HIP_MEMORY_SCOPE_AGENT); }
__device__ __forceinline__ unsigned xb_xcc_id() { return (unsigned)__builtin_amdgcn_s_getreg((3 << 11) | 20) & 0xFu; }
#define XB_SPIN(cond, bar) do { unsigned _sp = 0; while (cond) { __builtin_amdgcn_s_sleep(1); \
    if ((++_sp & 255u) == 0u) { if (xb_ld(&(bar)[XB_TMO])) break; if (_sp > XB_SPIN_CAP) { atomicAdd(&(bar)[XB_TMO], 1u); break; } } } } while (0)

struct XcdBarrier { unsigned* bar; unsigned x; volatile LAS unsigned* st; };

__device__ __forceinline__ XcdBarrier xcd_barrier_post(unsigned* bar, volatile LAS unsigned* st) {
    XcdBarrier b; b.bar = bar; b.x = xb_xcc_id(); b.st = st;
    if (threadIdx.x == 0) (void)xb_add(&bar[XB_XCNT(b.x)], 1u);
    return b;
}
__device__ __forceinline__ void xcd_barrier_complete(unsigned* bar, unsigned x, unsigned& nloc, unsigned& nx) {
    const unsigned G = gridDim.x * gridDim.y * gridDim.z;
    unsigned sum, cnt, mine, sp = 0u;
    for (;;) {
        sum = 0u; cnt = 0u; mine = 0u;
#pragma unroll
        for (unsigned j = 0; j < 16; ++j) { const unsigned c = xb_ld(&bar[XB_XCNT(j)]); sum += c; cnt += (c > 0u) ? 1u : 0u; mine = (j == x) ? c : mine; }
        if (sum == G) break;
        __builtin_amdgcn_s_sleep(1);
        if ((++sp & 255u) == 0u) { if (xb_ld(&bar[XB_TMO])) break; if (sp > XB_SPIN_CAP) { atomicAdd(&bar[XB_TMO], 1u); break; } }
    }
    nloc = mine > 0u ? mine : 1u; nx = cnt > 0u ? cnt : 1u;
}
__device__ __forceinline__ void xcd_barrier(const XcdBarrier& b) {
    asm volatile("s_waitcnt vmcnt(0)" ::: "memory");
    __syncthreads();
    if (threadIdx.x == 0) {
        unsigned* bar = b.bar;
        __builtin_amdgcn_s_waitcnt(0);
        unsigned nloc = b.st[0], nx = b.st[1];
        if (nloc == 0u) { xcd_barrier_complete(bar, b.x, nloc, nx); b.st[0] = nloc; b.st[1] = nx; }
        const unsigned old = xb_add(&bar[XB_XSUB(b.x)], 1u);
        const unsigned gen = old / nloc;
        if (old + 1u == (gen + 1u) * nloc) {
            __builtin_amdgcn_fence(__ATOMIC_RELEASE, "agent");
            asm volatile("s_waitcnt vmcnt(0)" ::: "memory");
            const unsigned og = xb_add(&bar[XB_TOP], 1u);
            const unsigned tg = og / nx;
            if (og + 1u == (tg + 1u) * nx) xb_add(&bar[XB_TOPGEN], 1u);
            else XB_SPIN(xb_ld(&bar[XB_TOPGEN]) == tg, bar);
            __builtin_amdgcn_fence(__ATOMIC_ACQUIRE, "agent");
            xb_add(&bar[XB_XGEN(b.x)], 1u);
            asm volatile("s_waitcnt vmcnt(0)" ::: "memory");
        } else {
            XB_SPIN(xb_ld(&bar[XB_XGEN(b.x)]) == gen, bar);
            __builtin_amdgcn_fence(__ATOMIC_ACQUIRE, "agent");
            asm volatile("s_waitcnt vmcnt(0)" ::: "memory");
        }
    }
    __syncthreads();
}

struct Args {
    const float *x_prompt, *x_sample, *p_prompt, *p_sample, *cache_k, *cache_v, *st_re, *st_im, *norm_gain, *w_in, *sinks, *w_o_attn,
                *a_re, *a_im, *log_dt, *b_re, *b_im, *c_re, *c_im, *ssm_d, *w_glu, *w_o_ssm, *w_out, *w_pg, *w_pp, *fgain;
    float* out; unsigned char* ws; int ph_lo, ph_hi;
};
typedef const __attribute__((address_space(4))) Args* AP;
__device__ __forceinline__ AP args_ptr() { AP p = (AP)__builtin_amdgcn_kernarg_segment_ptr(); asm volatile("" : "+s"(p)); return p; }

__device__ __forceinline__ float wave_sum(float v) {
#pragma unroll
    for (int o = 1; o < 64; o <<= 1) v += __shfl_xor(v, o);
    return v;
}
__device__ __forceinline__ void p0_transpose_item(const float* W, int K, int N, bf16* WT, int row_off, LAS float* scr, int item, int lane) {
    const int nblk = N / 32, kb = item / nblk, nb = item % nblk, k0 = 64 * kb, n0 = 32 * nb;
#pragma unroll 8
    for (int i = 0; i < 32; ++i) { const int kk = 2 * i + (lane >> 5); scr[kk * 33 + (lane & 31)] = W[(size_t)(k0 + kk) * N + n0 + (lane & 31)]; }
    LDS_WAIT(); asm volatile("" ::: "memory");
    const int c = lane & 7;
#pragma unroll
    for (int j = 0; j < 4; ++j) { const int n = (lane >> 3) + 8 * j; const LAS float* s = scr + (8 * c) * 33 + n;
        v4u o; o.x = pk2(s[0 * 33], s[1 * 33]); o.y = pk2(s[2 * 33], s[3 * 33]); o.z = pk2(s[4 * 33], s[5 * 33]); o.w = pk2(s[6 * 33], s[7 * 33]);
        *(GAS v4u*)(WT + (size_t)(row_off + n0 + n) * K + k0 + 8 * c) = o; }
    LDS_WAIT(); asm volatile("" ::: "memory");
}
__device__ __forceinline__ void rms_row_to_bf16(const float* xrow, const float* gain, bf16* orow, int lane) {
    const GAS f32x4* xr = (const GAS f32x4*)xrow + lane; const GAS f32x4* gr = (const GAS f32x4*)gain + lane;
    f32x4 v[4]; float s = 0.f;
#pragma unroll
    for (int j = 0; j < 4; ++j) { v[j] = xr[64 * j]; s += (v[j].x * v[j].x + v[j].y * v[j].y) + (v[j].z * v[j].z + v[j].w * v[j].w); }
    const float r = 1.f / sqrtf(wave_sum(s) * (1.f / DM) + EPS);
    GAS v2u* o8 = (GAS v2u*)orow + lane;
#pragma unroll
    for (int j = 0; j < 4; ++j) { const f32x4 g = gr[64 * j]; v2u o; o.x = pk2(v[j].x * r * g.x, v[j].y * r * g.y); o.y = pk2(v[j].z * r * g.z, v[j].w * r * g.w); o8[64 * j] = o; }
}
__device__ __forceinline__ void sincos_d(double x, double& s, double& c) {
    const double k = __builtin_rint(x * 0.63661977236758134);
    double r = __builtin_fma(-k, 1.5707963267948966, x); r = __builtin_fma(-k, 6.123233995736766e-17, r);
    const int q = ((int)k) & 3;
    const double r2 = r * r;
    double sp = 1.0 / 355687428096000.0;
    sp = sp * r2 - 1.0 / 1307674368000.0; sp = sp * r2 + 1.0 / 6227020800.0; sp = sp * r2 - 1.0 / 39916800.0; sp = sp * r2 + 1.0 / 362880.0;
    sp = sp * r2 - 1.0 / 5040.0; sp = sp * r2 + 1.0 / 120.0; sp = sp * r2 - 1.0 / 6.0; sp = sp * r2 + 1.0; sp = sp * r;
    double cp = 1.0 / 20922789888000.0;
    cp = cp * r2 - 1.0 / 87178291200.0; cp = cp * r2 + 1.0 / 479001600.0; cp = cp * r2 - 1.0 / 3628800.0; cp = cp * r2 + 1.0 / 40320.0;
    cp = cp * r2 - 1.0 / 720.0; cp = cp * r2 + 1.0 / 24.0; cp = cp * r2 - 0.5; cp = cp * r2 + 1.0;
    s = (q == 0) ? sp : (q == 1) ? cp : (q == 2) ? -sp : -cp;
    c = (q == 0) ? cp : (q == 1) ? -sp : (q == 2) ? -cp : sp;
}
__device__ __forceinline__ double exp_d(double x) {
    const double k = __builtin_rint(x * 1.4426950408889634);
    double r = __builtin_fma(-k, 0.6931471805599453, x); r = __builtin_fma(-k, 2.3190468138462996e-17, r);
    double p = 1.0 / 6227020800.0;
    p = p * r + 1.0 / 479001600.0; p = p * r + 1.0 / 39916800.0; p = p * r + 1.0 / 3628800.0; p = p * r + 1.0 / 362880.0; p = p * r + 1.0 / 40320.0; p = p * r + 1.0 / 5040.0;
    p = p * r + 1.0 / 720.0; p = p * r + 1.0 / 120.0; p = p * r + 1.0 / 24.0; p = p * r + 1.0 / 6.0; p = p * r + 0.5; p = p * r + 1.0; p = p * r + 1.0;
    const long long bits = (long long)(1023 + (int)k) << 52;
    return p * __builtin_bit_cast(double, bits);
}
__device__ __forceinline__ double expm1_small_d(double x) {
    double p = 1.0 / 479001600.0;
    p = p * x + 1.0 / 39916800.0; p = p * x + 1.0 / 3628800.0; p = p * x + 1.0 / 362880.0; p = p * x + 1.0 / 40320.0; p = p * x + 1.0 / 5040.0;
    p = p * x + 1.0 / 720.0; p = p * x + 1.0 / 120.0; p = p * x + 1.0 / 24.0; p = p * x + 1.0 / 6.0; p = p * x + 0.5; p = p * x + 1.0;
    return p * x;
}

__device__ __forceinline__ void p0_prologue(AP a, LAS unsigned char* lds, int wave, int lane) {
    unsigned char* ws = a->ws;
    LAS float* scr = (LAS float*)(lds + wave * 16384);
    const int gw = blockIdx.x * NWAVES + wave, NGW = gridDim.x * NWAVES;
    const int gt = gw * 64 + lane, NGT = NGW * 64;
    constexpr int I_IN = (1024 / 64) * (INW / 32), I_OA = (512 / 64) * (1024 / 32), I_OS = I_OA, I_GL = (512 / 64) * (512 / 32), I_OUT = (1024 / 64) * (1024 / 32), I_PG = I_OUT, I_PP = (256 / 64) * (1024 / 32);
    constexpr int NITEMS = I_IN + I_OA + I_OS + I_GL + I_OUT + I_PG + I_PP;
    for (int it = gw; it < NITEMS; it += NGW) {
        int r = it;
        if (r < I_IN)  { p0_transpose_item(a->w_in, 1024, INW, (bf16*)(ws + WS_WIN), 0, scr, r, lane); continue; } r -= I_IN;
        if (r < I_OA)  { p0_transpose_item(a->w_o_attn, 512, 1024, (bf16*)(ws + WS_WST), 0, scr, r, lane); continue; } r -= I_OA;
        if (r < I_OS)  { p0_transpose_item(a->w_o_ssm, 512, 1024, (bf16*)(ws + WS_WST), 1024, scr, r, lane); continue; } r -= I_OS;
        if (r < I_GL)  { p0_transpose_item(a->w_glu, 512, 512, (bf16*)(ws + WS_WGLU), 0, scr, r, lane); continue; } r -= I_GL;
        if (r < I_OUT) { p0_transpose_item(a->w_out, 1024, 1024, (bf16*)(ws + WS_WOUT), 0, scr, r, lane); continue; } r -= I_OUT;
        if (r < I_PG)  { p0_transpose_item(a->w_pg, 1024, 1024, (bf16*)(ws + WS_WPG), 0, scr, r, lane); continue; } r -= I_PG;
        p0_transpose_item(a->w_pp, 256, 1024, (bf16*)(ws + WS_WPP), 0, scr, r, lane);
    }
    for (int m = gw; m < M; m += NGW) {
        const float* xrow = m < MP ? a->x_prompt + (size_t)m * DM : a->x_sample + (size_t)(m - MP) * DM;
        rms_row_to_bf16(xrow, a->norm_gain, (bf16*)(ws + WS_XN) + (size_t)m * DM, lane);
        const float* prow = m < MP ? a->p_prompt + (size_t)m * PLE : a->p_sample + (size_t)(m - MP) * PLE;
        const f32x4 pv = ((const GAS f32x4*)prow)[lane];
        v2u o; o.x = pk2(pv.x, pv.y); o.y = pk2(pv.z, pv.w);
        ((GAS v2u*)((bf16*)(ws + WS_P) + (size_t)m * PLE))[lane] = o;
    }
    for (int i = gt; i < 2 * 16384; i += NGT) {
        const int which = i >> 14, j = i & 16383, b = j >> 11, r = j & 2047;
        const float* src = (which ? a->cache_v : a->cache_k) + (size_t)b * 16384 + 8192;
        float* dst = a->out + (which ? OFF_VS : OFF_KS) + (size_t)b * 16384;
        ((GAS f32x4*)dst)[r] = ((const GAS f32x4*)src)[r];
    }
    for (int i = gt; i < 2048 * 8; i += NGT) {
        const int pos = i >> 3, f = i & 7;
        const double INV[8] = {1.0, 0.19392274474868576, 0.03760603093086393, 0.007292664737217109, 0.001414213562373095, 0.0002742481756762073, 5.318295896944988e-05, 1.031338537721246e-05};
        double inv = INV[0];
#pragma unroll
        for (int q = 1; q < 8; ++q) inv = (f == q) ? INV[q] : inv;
        const float ang = (float)pos * (float)inv;
        double s, c; sincos_d((double)ang, s, c);
        float* rt = (float*)(ws + WS_ROPE) + (size_t)i * 2; rt[0] = (float)c; rt[1] = (float)s;
    }
    for (int it = gt; it < 32 * 64; it += NGT) {
        const int g = it >> 6, p = it & 63;
        const double lr = (double)a->a_re[it], li = (double)a->a_im[it], dt = exp_d((double)a->log_dt[g]);
        const double xr = lr * dt, th = li * dt;
        double sn, cs, sh, ch; sincos_d(th, sn, cs); sincos_d(0.5 * th, sh, ch);
        const double em1 = expm1_small_d(xr), ex = em1 + 1.0;
        const double ar = ex * cs, ai = ex * sn;
        const double ur = em1 * cs - 2.0 * sh * sh, ui = ai;
        const double den = lr * lr + li * li;
        const double cr = (ur * lr + ui * li) / den, ci = (ui * lr - ur * li) / den;
        bf16* Bb = (bf16*)(ws + WS_SSMB);
#pragma unroll
        for (int c = 0; c < 16; ++c) {
            const double br = (double)a->b_re[(size_t)it * 16 + c], bi = (double)a->b_im[(size_t)it * 16 + c];
            Bb[(size_t)(g * 128 + p) * 16 + c] = f2bf((float)(cr * br - ci * bi));
            Bb[(size_t)(g * 128 + 64 + p) * 16 + c] = f2bf((float)(cr * bi + ci * br));
        }
        bf16* Cm = (bf16*)(ws + WS_SSMC);
        const int kq = 4 * (p & 31) + 2 * (p >> 5);
#pragma unroll
        for (int co = 0; co < 16; ++co) {
            Cm[(size_t)(g * 16 + co) * 128 + kq] = f2bf(a->c_re[(size_t)(g * 16 + co) * 64 + p]);
            Cm[(size_t)(g * 16 + co) * 128 + kq + 1] = f2bf(-a->c_im[(size_t)(g * 16 + co) * 64 + p]);
        }
        float* ap = (float*)(ws + WS_APOW) + (size_t)it * 12;
        const double a2r = ar * ar - ai * ai, a2i = 2.0 * ar * ai;
        const double a3r = a2r * ar - a2i * ai, a3i = a2r * ai + a2i * ar;
        const double a4r = a2r * a2r - a2i * a2i, a4i = 2.0 * a2r * a2i;
        const double a8r = a4r * a4r - a4i * a4i, a8i = 2.0 * a4r * a4i;
        double pr = a8r, pi = a8i;
#pragma unroll
        for (int q = 0; q < 3; ++q) { const double t = pr * pr - pi * pi; pi = 2.0 * pr * pi; pr = t; }
        ap[0] = (float)ar; ap[1] = (float)ai; ap[2] = (float)a2r; ap[3] = (float)a2i; ap[4] = (float)a3r; ap[5] = (float)a3i;
        ap[6] = (float)a4r; ap[7] = (float)a4i; ap[8] = (float)a8r; ap[9] = (float)a8i; ap[10] = (float)pr; ap[11] = (float)pi;
    }
}

#define MFMA32(a, b, c) __builtin_amdgcn_mfma_f32_32x32x16_bf16((a), (b), (c), 0, 0, 0)
#define MFMA16(a, b, c) __builtin_amdgcn_mfma_f32_16x16x32_bf16((a), (b), (c), 0, 0, 0)
__device__ __forceinline__ bf16x8 pack_regs8(const f32x16& x, const int s) {
    v4u p; p.x = cvtpk_s(x[8 * s + 0], x[8 * s + 1]); p.y = cvtpk_s(x[8 * s + 2], x[8 * s + 3]); p.z = cvtpk_s(x[8 * s + 4], x[8 * s + 5]); p.w = cvtpk_s(x[8 * s + 6], x[8 * s + 7]);
    return __builtin_bit_cast(bf16x8, p);
}
__device__ __forceinline__ void attn_unit(AP a, LAS unsigned char* lds, int unit, int tid, int wave, int lane) {
    asm volatile("" : "+v"(tid), "+v"(lane));
    unsigned char* ws = a->ws;
    const bf16* Qb = (const bf16*)(ws + WS_Q); const bf16* Kb = (const bf16*)(ws + WS_K); const bf16* Vb = (const bf16*)(ws + WS_V);
    const bf16* ZA = (const bf16*)(ws + WS_ZA); bf16* A1 = (bf16*)(ws + WS_AST);
    const int kvh = unit & 1;
    const bool smp = unit >= 512;
    const int cr = smp ? 256 + ((unit - 512) >> 1) : (unit >> 1);
    const int row0 = cr * 64, c = cr & 31;
    const int kb_lo = smp ? 0 : (c >= 2 ? 0 : (2 - c) * 2);
#pragma unroll
    for (int i = 0; i < 3; ++i) {
        const int q = tid + 512 * i, key = q >> 3, ch = q & 7;
        v4u kv = {0u, 0u, 0u, 0u}, vv = {0u, 0u, 0u, 0u};
        if (smp) {
            if (key < 128) {
                const size_t o = ((size_t)((cr - 256) * 128 + key) * 2 + kvh) * 64 + ch * 8;
                const f32x4 k0 = *(const GAS f32x4*)(a->cache_k + o), k1 = *(const GAS f32x4*)(a->cache_k + o + 4);
                const f32x4 v0 = *(const GAS f32x4*)(a->cache_v + o), v1 = *(const GAS f32x4*)(a->cache_v + o + 4);
                kv.x = pk2(k0.x, k0.y); kv.y = pk2(k0.z, k0.w); kv.z = pk2(k1.x, k1.y); kv.w = pk2(k1.z, k1.w);
                vv.x = pk2(v0.x, v0.y); vv.y = pk2(v0.z, v0.w); vv.z = pk2(v1.x, v1.y); vv.w = pk2(v1.z, v1.w);
            } else {
                const size_t o = (size_t)(row0 + key - 128) * 128 + kvh * 64 + ch * 8;
                kv = *(const GAS v4u*)(Kb + o); vv = *(const GAS v4u*)(Vb + o);
            }
        } else {
            const int kc = key >> 6;
            if (c - 2 + kc >= 0) {
                const size_t o = (size_t)(row0 + (kc - 2) * 64 + (key & 63)) * 128 + kvh * 64 + ch * 8;
                kv = *(const GAS v4u*)(Kb + o); vv = *(const GAS v4u*)(Vb + o);
            }
        }
        *(LAS v4u*)(lds + LDS_KL + key * KL_STRIDE + ch * 16) = kv;
        const int w = key & 15, pos = (key & ~15) | (w & 3) | ((w & 4) << 1) | ((w & 8) >> 1);
        LAS bf16* vt = (LAS bf16*)(lds + LDS_VT) + pos;
        const int d0 = ch * 8;
        vt[(d0 + 0) * (VT_STRIDE / 2)] = (bf16)(vv.x & 0xffffu); vt[(d0 + 1) * (VT_STRIDE / 2)] = (bf16)(vv.x >> 16);
        vt[(d0 + 2) * (VT_STRIDE / 2)] = (bf16)(vv.y & 0xffffu); vt[(d0 + 3) * (VT_STRIDE / 2)] = (bf16)(vv.y >> 16);
        vt[(d0 + 4) * (VT_STRIDE / 2)] = (bf16)(vv.z & 0xffffu); vt[(d0 + 5) * (VT_STRIDE / 2)] = (bf16)(vv.z >> 16);
        vt[(d0 + 6) * (VT_STRIDE / 2)] = (bf16)(vv.w & 0xffffu); vt[(d0 + 7) * (VT_STRIDE / 2)] = (bf16)(vv.w >> 16);
    }
    __syncthreads();
    const int hq = kvh * 4 + (wave >> 1), th = wave & 1, r32 = lane & 31, h = lane >> 5;
    const int qrow = row0 + th * 32 + r32;
    bf16x8 qf[4];
#pragma unroll
    for (int s = 0; s < 4; ++s) qf[s] = *(const GAS bf16x8*)(Qb + (size_t)qrow * 512 + hq * 64 + 16 * s + 8 * h);
    f32x16 st[6];
    const float SC = 0.125f * 1.4426950408889634f;
    const float sink2 = a->sinks[hq] * 1.4426950408889634f;
    float mx = sink2;
#pragma unroll
    for (int kb = 0; kb < 6; ++kb) {
#pragma unroll
        for (int r = 0; r < 16; ++r) st[kb][r] = 0.f;
        if (kb >= kb_lo) {
#pragma unroll
            for (int s = 0; s < 4; ++s) {
                const bf16x8 kf = *(const LAS bf16x8*)(lds + LDS_KL + (kb * 32 + r32) * KL_STRIDE + (16 * s + 8 * h) * 2);
                st[kb] = MFMA32(kf, qf[s], st[kb]);
            }
#pragma unroll
            for (int r = 0; r < 16; ++r) { st[kb][r] *= SC; mx = fmaxf(mx, st[kb][r]); }
        }
    }
    mx = fmaxf(mx, __shfl_xor(mx, 32));
    float sum = 0.f;
#pragma unroll
    for (int kb = 0; kb < 6; ++kb) {
        if (kb >= kb_lo) {
#pragma unroll
            for (int r = 0; r < 16; ++r) { const float e = __builtin_amdgcn_exp2f(st[kb][r] - mx); st[kb][r] = e; sum += e; }
        }
    }
    sum += __shfl_xor(sum, 32);
    const float inv = 1.0f / (sum + __builtin_amdgcn_exp2f(sink2 - mx));
    f32x16 o[2];
#pragma unroll
    for (int db = 0; db < 2; ++db)
#pragma unroll
        for (int r = 0; r < 16; ++r) o[db][r] = 0.f;
#pragma unroll
    for (int kb = 0; kb < 6; ++kb) {
        if (kb >= kb_lo) {
#pragma unroll
            for (int s = 0; s < 2; ++s) {
                const bf16x8 pf = pack_regs8(st[kb], s);
#pragma unroll
                for (int db = 0; db < 2; ++db) {
                    const bf16x8 vf = *(const LAS bf16x8*)(lds + LDS_VT + (db * 32 + r32) * VT_STRIDE + (kb * 32 + 16 * s + 8 * h) * 2);
                    o[db] = MFMA32(vf, pf, o[db]);
                }
            }
        }
    }
#pragma unroll
    for (int db = 0; db < 2; ++db)
#pragma unroll
        for (int g4 = 0; g4 < 4; ++g4) {
            const size_t off = (size_t)qrow * 512 + hq * 64 + db * 32 + 8 * g4 + 4 * h;
            const v2u z = *(const GAS v2u*)(ZA + off);
            v2u w; w.x = pk2(o[db][4 * g4 + 0] * inv * bf_lo(z.x), o[db][4 * g4 + 1] * inv * bf_hi(z.x)); w.y = pk2(o[db][4 * g4 + 2] * inv * bf_lo(z.y), o[db][4 * g4 + 3] * inv * bf_hi(z.y));
            *(GAS v2u*)(A1 + off) = w;
        }
    __syncthreads();
}

template <bool FULL>
__device__ __forceinline__ void ssm_group(AP a, LAS unsigned char* lds, int cr, int g, int wave, int lane) {
    asm volatile("" : "+v"(lane));
    unsigned char* ws = a->ws;
    const bf16* U = (const bf16*)(ws + WS_U); const bf16* Bb = (const bf16*)(ws + WS_SSMB); const bf16* Cm = (const bf16*)(ws + WS_SSMC);
    const float* apow = (const float*)(ws + WS_APOW);
    const int p32 = lane & 31, h = lane >> 5, row0 = cr * 64;
    LAS unsigned char* Hl = lds + LDS_HL + wave * HL_WAVE;
    const LAS float* Hp = (const LAS float*)(lds + LDS_HP);
    bf16x8 bb[4];
#pragma unroll
    for (int nb = 0; nb < 4; ++nb) bb[nb] = *(const GAS bf16x8*)(Bb + (size_t)(g * 128 + nb * 32 + p32) * 16 + 8 * h);
    float A1r[2], A1i[2], A2r[2], A2i[2], A3r[2], A3i[2], A4r[2], A4i[2], A8r[2], A8i[2], cyr[2], cyi[2];
#pragma unroll
    for (int pi = 0; pi < 2; ++pi) {
        const f32x4* ap = (const f32x4*)(apow + (size_t)(g * 64 + pi * 32 + p32) * 12);
        const f32x4 q0 = ap[0], q1 = ap[1], q2 = ap[2];
        A1r[pi] = q0[0]; A1i[pi] = q0[1]; A2r[pi] = q0[2]; A2i[pi] = q0[3]; A3r[pi] = q1[0]; A3i[pi] = q1[1]; A4r[pi] = q1[2]; A4i[pi] = q1[3]; A8r[pi] = q2[0]; A8i[pi] = q2[1];
        if (FULL) { cyr[pi] = Hp[g * 128 + pi * 32 + p32]; cyi[pi] = Hp[g * 128 + 64 + pi * 32 + p32]; } else { cyr[pi] = 0.f; cyi[pi] = 0.f; }
    }
    bf16x8 cmf[4];
    if (FULL) {
#pragma unroll
        for (int ks = 0; ks < 4; ++ks) cmf[ks] = *(const GAS bf16x8*)(Cm + (size_t)(g * 16 + (lane & 15)) * 128 + 32 * ks + 8 * (lane >> 4));
    }
#pragma unroll
    for (int tb = 0; tb < 2; ++tb) {
        const bf16x8 uf = *(const GAS bf16x8*)(U + (size_t)(row0 + tb * 32 + p32) * 512 + g * 16 + 8 * h);
        f32x16 x[4];
#pragma unroll
        for (int nb = 0; nb < 4; ++nb) {
#pragma unroll
            for (int r = 0; r < 16; ++r) x[nb][r] = 0.f;
            x[nb] = MFMA32(uf, bb[nb], x[nb]);
        }
#pragma unroll
        for (int pi = 0; pi < 2; ++pi) {
            f32x16& xr = x[pi]; f32x16& xi = x[2 + pi];
            const float a1r = A1r[pi], a1i = A1i[pi], a4r = A4r[pi], a4i = A4i[pi], a8r = A8r[pi], a8i = A8i[pi];
#pragma unroll
            for (int j = 0; j < 4; ++j) {
#pragma unroll
                for (int i = 1; i < 4; ++i) {
                    const float pr = xr[4 * j + i - 1], pim = xi[4 * j + i - 1];
                    xr[4 * j + i] += a1r * pr - a1i * pim;
                    xi[4 * j + i] += a1r * pim + a1i * pr;
                }
            }
            float Cr = cyr[pi], Ci = cyi[pi];
            float car[4], cai[4];
#pragma unroll
            for (int j = 0; j < 4; ++j) {
                const float er = xr[4 * j + 3], ei = xi[4 * j + 3];
                const float per = __shfl_xor(er, 32), pei = __shfl_xor(ei, 32);
                const float evr = h == 0 ? er : per, evi = h == 0 ? ei : pei;
                const float odr = h == 0 ? per : er, odi = h == 0 ? pei : ei;
                const float t4r = a4r * Cr - a4i * Ci + evr, t4i = a4r * Ci + a4i * Cr + evi;
                car[j] = h == 0 ? Cr : t4r; cai[j] = h == 0 ? Ci : t4i;
                const float Er = a4r * evr - a4i * evi + odr, Ei = a4r * evi + a4i * evr + odi;
                const float nr = a8r * Cr - a8i * Ci + Er, ni = a8r * Ci + a8i * Cr + Ei;
                Cr = nr; Ci = ni;
            }
            cyr[pi] = Cr; cyi[pi] = Ci;
            if (FULL) {
                const float pw_r[4] = {a1r, A2r[pi], A3r[pi], a4r}, pw_i[4] = {a1i, A2i[pi], A3i[pi], a4i};
#pragma unroll
                for (int j = 0; j < 4; ++j)
#pragma unroll
                    for (int i = 0; i < 4; ++i) {
                        const float hr = xr[4 * j + i] + pw_r[i] * car[j] - pw_i[i] * cai[j];
                        const float hi = xi[4 * j + i] + pw_r[i] * cai[j] + pw_i[i] * car[j];
                        const int trow = i + 8 * j + 4 * h;
                        *(LAS unsigned*)(Hl + trow * HL_STRIDE + p32 * 8 + pi * 4) = cvtpk_s(hr, hi);
                    }
            }
        }
        if (FULL) {
            const bf16* ZSdummy = nullptr; (void)ZSdummy;
            LAS unsigned char* Zl = lds + LDS_ZL;
            const int t16 = lane & 15, q4 = lane >> 4, ch = g * 16 + 4 * q4;
            const f32x4 dsk = *(const GAS f32x4*)(a->ssm_d + ch);
#pragma unroll
            for (int mt = 0; mt < 2; ++mt) {
                f32x4 ya = {0.f, 0.f, 0.f, 0.f};
#pragma unroll
                for (int ks = 0; ks < 4; ++ks) {
                    const bf16x8 hb = *(const LAS bf16x8*)(Hl + (16 * mt + t16) * HL_STRIDE + (32 * ks + 8 * q4) * 2);
                    ya = MFMA16(cmf[ks], hb, ya);
                }
                const int t = tb * 32 + 16 * mt + t16;
                const v2u uu = *(const GAS v2u*)(U + (size_t)(row0 + t) * 512 + ch);
                const float z0 = gelu_tanh_f(ya[0] + dsk[0] * bf_lo(uu.x)), z1 = gelu_tanh_f(ya[1] + dsk[1] * bf_hi(uu.x));
                const float z2 = gelu_tanh_f(ya[2] + dsk[2] * bf_lo(uu.y)), z3 = gelu_tanh_f(ya[3] + dsk[3] * bf_hi(uu.y));
                v2u w; w.x = pk2(z0, z1); w.y = pk2(z2, z3);
                *(LAS v2u*)(Zl + t * ZL_STRIDE + ch * 2) = w;
            }
        }
    }
    if (!FULL) {
        if (h == 0) {
            float* S = (float*)(ws + WS_SLOC) + (size_t)(cr * 32 + g) * 128;
#pragma unroll
            for (int pi = 0; pi < 2; ++pi) { S[pi * 32 + p32] = cyr[pi]; S[64 + pi * 32 + p32] = cyi[pi]; }
        }
    } else {
        const bool smp = cr >= 256;
        if ((smp || (cr & 31) == 31) && h == 0) {
            const int b = smp ? cr - 256 : cr >> 5;
            float* sr = a->out + (smp ? OFF_SRS : OFF_SRP) + (size_t)(b * 32 + g) * 64;
            float* si = a->out + (smp ? OFF_SIS : OFF_SIP) + (size_t)(b * 32 + g) * 64;
#pragma unroll
            for (int pi = 0; pi < 2; ++pi) { sr[pi * 32 + p32] = cyr[pi]; si[pi * 32 + p32] = cyi[pi]; }
        }
    }
}

__device__ __forceinline__ void ssm_local_unit(AP a, LAS unsigned char* lds, int cr, int wave, int lane) {
    for (int gi = 0; gi < 4; ++gi) ssm_group<false>(a, lds, cr, wave * 4 + gi, wave, lane);
}

__device__ __forceinline__ void ssm_full_unit(AP a, LAS unsigned char* lds, int cr, int tid, int wave, int lane) {
    asm volatile("" : "+v"(tid), "+v"(lane));
    unsigned char* ws = a->ws;
    const bool smp = cr >= 256; const int c = cr & 31, b = smp ? cr - 256 : cr >> 5, row0 = cr * 64;
    LAS float* Hp = (LAS float*)(lds + LDS_HP);
    const float* apow = (const float*)(ws + WS_APOW);
    const float* Sl = (const float*)(ws + WS_SLOC);
    {
        float hr[4] = {0.f, 0.f, 0.f, 0.f}, hi[4] = {0.f, 0.f, 0.f, 0.f};
        if (smp) {
#pragma unroll
            for (int i = 0; i < 4; ++i) { const int ci = tid + 512 * i; hr[i] = a->st_re[(size_t)b * 2048 + ci]; hi[i] = a->st_im[(size_t)b * 2048 + ci]; }
        } else if (c > 0) {
            float ar[4], ai[4];
#pragma unroll
            for (int i = 0; i < 4; ++i) { const int ci = tid + 512 * i; ar[i] = apow[(size_t)ci * 12 + 10]; ai[i] = apow[(size_t)ci * 12 + 11]; }
            for (int j0 = 0; j0 < c; j0 += 8) {
                float sr[8][4], si[8][4];
#pragma unroll
                for (int jj = 0; jj < 8; ++jj) {
                    const int j = (j0 + jj < c) ? j0 + jj : c - 1;
#pragma unroll
                    for (int i = 0; i < 4; ++i) { const int ci = tid + 512 * i; const float* S = Sl + (size_t)((b * 32 + j) * 32 + (ci >> 6)) * 128 + (ci & 63); sr[jj][i] = S[0]; si[jj][i] = S[64]; }
                }
#pragma unroll
                for (int jj = 0; jj < 8; ++jj) {
                    if (j0 + jj < c) {
#pragma unroll
                        for (int i = 0; i < 4; ++i) { const float nr = ar[i] * hr[i] - ai[i] * hi[i] + sr[jj][i], ni = ar[i] * hi[i] + ai[i] * hr[i] + si[jj][i]; hr[i] = nr; hi[i] = ni; }
                    }
                }
            }
        }
#pragma unroll
        for (int i = 0; i < 4; ++i) { const int ci = tid + 512 * i, g = ci >> 6, p = ci & 63; Hp[g * 128 + p] = hr[i]; Hp[g * 128 + 64 + p] = hi[i]; }
    }
    __syncthreads();
    for (int gi = 0; gi < 4; ++gi) ssm_group<true>(a, lds, cr, wave * 4 + gi, wave, lane);
    __syncthreads();
    {
        const bf16* Wg = (const bf16*)(ws + WS_WGLU); const bf16* ZS = (const bf16*)(ws + WS_ZS); bf16* S1 = (bf16*)(ws + WS_AST) + (size_t)M * 512;
        LAS unsigned char* Zl = lds + LDS_ZL;
        asm volatile("" : "+v"(lane));
        const int t16 = lane & 15, q4 = lane >> 4;
        f32x4 acc[4][4];
#pragma unroll
        for (int nt = 0; nt < 4; ++nt)
#pragma unroll
            for (int mt = 0; mt < 4; ++mt) acc[nt][mt] = (f32x4){0.f, 0.f, 0.f, 0.f};
#pragma unroll 4
        for (int ks = 0; ks < 16; ++ks) {
            bf16x8 af[4], zf[4];
#pragma unroll
            for (int nt = 0; nt < 4; ++nt) af[nt] = *(const GAS bf16x8*)(Wg + (size_t)(64 * wave + 16 * nt + t16) * 512 + 32 * ks + 8 * q4);
#pragma unroll
            for (int mt = 0; mt < 4; ++mt) zf[mt] = *(const LAS bf16x8*)(Zl + (16 * mt + t16) * ZL_STRIDE + (32 * ks + 8 * q4) * 2);
#pragma unroll
            for (int nt = 0; nt < 4; ++nt)
#pragma unroll
                for (int mt = 0; mt < 4; ++mt) acc[nt][mt] = MFMA16(af[nt], zf[mt], acc[nt][mt]);
        }
#pragma unroll
        for (int nt = 0; nt < 4; ++nt)
#pragma unroll
            for (int mt = 0; mt < 4; ++mt) {
                const int n0 = 64 * wave + 16 * nt + 4 * q4, t = 16 * mt + t16;
                const v2u z = *(const LAS v2u*)(Zl + t * ZL_STRIDE + n0 * 2);
                const v2u zs = *(const GAS v2u*)(ZS + (size_t)(row0 + t) * 512 + n0);
                const f32x4 gt = acc[nt][mt];
                v2u w;
                w.x = pk2(bf_lo(z.x) * sigmoid_f(gt[0]) * bf_lo(zs.x), bf_hi(z.x) * sigmoid_f(gt[1]) * bf_hi(zs.x));
                w.y = pk2(bf_lo(z.y) * sigmoid_f(gt[2]) * bf_lo(zs.y), bf_hi(z.y) * sigmoid_f(gt[3]) * bf_hi(zs.y));
                *(GAS v2u*)(S1 + (size_t)(row0 + t) * 512 + n0) = w;
            }
    }
    __syncthreads();
}


constexpr int MPT_STRIDE = 272, MPT_WAVE = 32 * MPT_STRIDE;
__device__ __forceinline__ void mini_acc(f32x4 (&acc)[2][4], const bf16* A, int lda, const bf16* Bt, int ldb, int kbeg, int ksteps, int lane) {
    const int l16 = lane & 15, q4 = lane >> 4;
    for (int ks = 0; ks < ksteps; ++ks) {
        const int k = kbeg + 32 * ks + 8 * q4;
        bf16x8 af[2], bfr[4];
#pragma unroll
        for (int mt = 0; mt < 2; ++mt) af[mt] = *(const GAS bf16x8*)(A + (size_t)(16 * mt + l16) * lda + k);
#pragma unroll
        for (int nt = 0; nt < 4; ++nt) bfr[nt] = *(const GAS bf16x8*)(Bt + (size_t)(16 * nt + l16) * ldb + k);
#pragma unroll
        for (int mt = 0; mt < 2; ++mt)
#pragma unroll
            for (int nt = 0; nt < 4; ++nt) acc[mt][nt] = MFMA16(bfr[nt], af[mt], acc[mt][nt]);
    }
}
__device__ __forceinline__ f32x4 mini_reduce(LAS unsigned char* lds, const f32x4 (&acc)[2][4], int tid, int wave, int lane) {
    const int l16 = lane & 15, q4 = lane >> 4;
#pragma unroll
    for (int mt = 0; mt < 2; ++mt)
#pragma unroll
        for (int nt = 0; nt < 4; ++nt) *(LAS f32x4*)(lds + wave * MPT_WAVE + (16 * mt + l16) * MPT_STRIDE + (16 * nt + 4 * q4) * 4) = acc[mt][nt];
    __syncthreads();
    const int t = tid >> 4, n4 = (tid & 15) * 4;
    f32x4 s = {0.f, 0.f, 0.f, 0.f};
#pragma unroll
    for (int w = 0; w < NWAVES; ++w) s += *(const LAS f32x4*)(lds + w * MPT_WAVE + t * MPT_STRIDE + n4 * 4);
    __syncthreads();
    return s;
}
#define MINI_ZERO(acc) _Pragma("unroll") for (int _m = 0; _m < 2; ++_m) _Pragma("unroll") for (int _n = 0; _n < 4; ++_n) acc[_m][_n] = (f32x4){0.f, 0.f, 0.f, 0.f}
__device__ __forceinline__ void mini_merge(AP a, LAS unsigned char* lds, int item, int tid, int wave, int lane) {
    asm volatile("" : "+v"(tid), "+v"(lane));
    unsigned char* ws = a->ws;
    const int rb = item >> 4, cb = item & 15, r0 = MP + 32 * rb, n0 = 64 * cb;
    const bf16* AST = (const bf16*)(ws + WS_AST); const bf16* WST = (const bf16*)(ws + WS_WST);
    f32x4 ya[2][4], ys[2][4]; MINI_ZERO(ya); MINI_ZERO(ys);
    mini_acc(ya, AST + (size_t)r0 * 512, 512, WST + (size_t)n0 * 512, 512, wave * 64, 2, lane);
    mini_acc(ys, AST + (size_t)(M + r0) * 512, 512, WST + (size_t)(1024 + n0) * 512, 512, wave * 64, 2, lane);
    const bf16* GA = (const bf16*)(ws + WS_GA); const bf16* GS = (const bf16*)(ws + WS_GS);
    const int l16 = lane & 15, q4 = lane >> 4;
#pragma unroll
    for (int mt = 0; mt < 2; ++mt)
#pragma unroll
        for (int nt = 0; nt < 4; ++nt) {
            const size_t o = (size_t)(r0 + 16 * mt + l16) * DM + n0 + 16 * nt + 4 * q4;
            const v2u ga = *(const GAS v2u*)(GA + o), gs = *(const GAS v2u*)(GS + o);
            ya[mt][nt][0] = ya[mt][nt][0] * bf_lo(ga.x) + ys[mt][nt][0] * bf_lo(gs.x); ya[mt][nt][1] = ya[mt][nt][1] * bf_hi(ga.x) + ys[mt][nt][1] * bf_hi(gs.x);
            ya[mt][nt][2] = ya[mt][nt][2] * bf_lo(ga.y) + ys[mt][nt][2] * bf_lo(gs.y); ya[mt][nt][3] = ya[mt][nt][3] * bf_hi(ga.y) + ys[mt][nt][3] * bf_hi(gs.y);
        }
    const f32x4 v = mini_reduce(lds, ya, tid, wave, lane);
    const int t = tid >> 4, n4 = (tid & 15) * 4;
    v2u w; w.x = pk2(v[0], v[1]); w.y = pk2(v[2], v[3]);
    *(GAS v2u*)((bf16*)(ws + WS_XN) + (size_t)(r0 + t) * DM + n0 + n4) = w;
}
__device__ __forceinline__ void mini_h1_pp(AP a, LAS unsigned char* lds, int item, int tid, int wave, int lane) {
    asm volatile("" : "+v"(tid), "+v"(lane));
    unsigned char* ws = a->ws;
    const int rb = item >> 4, cb = item & 15, r0 = MP + 32 * rb, n0 = 64 * cb;
    const int t = tid >> 4, n4 = (tid & 15) * 4;
    {
        f32x4 acc[2][4]; MINI_ZERO(acc);
        mini_acc(acc, (const bf16*)(ws + WS_XN) + (size_t)r0 * DM, DM, (const bf16*)(ws + WS_WOUT) + (size_t)n0 * DM, DM, wave * 128, 4, lane);
        const f32x4 v = mini_reduce(lds, acc, tid, wave, lane);
        const size_t o = (size_t)(r0 + t) * DM + n0 + n4;
        const f32x4 h = *(const GAS f32x4*)(a->x_sample + (o - (size_t)MP * DM)) + v;
        *(GAS f32x4*)(a->out + o) = h;
        v2u w; w.x = pk2(h[0], h[1]); w.y = pk2(h[2], h[3]);
        *(GAS v2u*)((bf16*)(ws + WS_GA) + o) = w;
    }
    {
        f32x4 acc[2][4]; MINI_ZERO(acc);
        mini_acc(acc, (const bf16*)(ws + WS_P) + (size_t)r0 * PLE, PLE, (const bf16*)(ws + WS_WPP) + (size_t)n0 * PLE, PLE, wave * 32, 1, lane);
        const f32x4 v = mini_reduce(lds, acc, tid, wave, lane);
        v2u w; w.x = pk2(v[0], v[1]); w.y = pk2(v[2], v[3]);
        *(GAS v2u*)((bf16*)(ws + WS_GS) + (size_t)(r0 + t) * DM + n0 + n4) = w;
    }
}
__device__ __forceinline__ void mini_h2(AP a, LAS unsigned char* lds, int item, int tid, int wave, int lane) {
    asm volatile("" : "+v"(tid), "+v"(lane));
    unsigned char* ws = a->ws;
    const int rb = item >> 4, cb = item & 15, r0 = MP + 32 * rb, n0 = 64 * cb;
    const int t = tid >> 4, n4 = (tid & 15) * 4;
    f32x4 acc[2][4]; MINI_ZERO(acc);
    mini_acc(acc, (const bf16*)(ws + WS_GA) + (size_t)r0 * DM, DM, (const bf16*)(ws + WS_WPG) + (size_t)n0 * DM, DM, wave * 128, 4, lane);
    const f32x4 v = mini_reduce(lds, acc, tid, wave, lane);
    const size_t o = (size_t)(r0 + t) * DM + n0 + n4;
    const v2u pp = *(const GAS v2u*)((const bf16*)(ws + WS_GS) + o);
    f32x4 h = *(const GAS f32x4*)(a->out + o);
    h[0] += sigmoid_f(v[0]) * bf_lo(pp.x); h[1] += sigmoid_f(v[1]) * bf_hi(pp.x); h[2] += sigmoid_f(v[2]) * bf_lo(pp.y); h[3] += sigmoid_f(v[3]) * bf_hi(pp.y);
    *(GAS f32x4*)(a->out + o) = h;
    float sq = (h[0] * h[0] + h[1] * h[1]) + (h[2] * h[2] + h[3] * h[3]);
    sq += __shfl_xor(sq, 1); sq += __shfl_xor(sq, 2); sq += __shfl_xor(sq, 4); sq += __shfl_xor(sq, 8);
    if ((tid & 15) == 0) ((float*)(ws + WS_SSQ))[(size_t)(r0 + t) * 16 + cb] = sq;
}

__device__ __forceinline__ void final_norm_row(AP a, int m, int lane) {
    GAS f32x4* yr = (GAS f32x4*)(a->out + (size_t)m * DM) + lane; const GAS f32x4* gr = (const GAS f32x4*)a->fgain + lane;
    const float* sq = (const float*)(a->ws + WS_SSQ) + (size_t)m * 16;
    const f32x4 s0 = *(const GAS f32x4*)sq, s1 = *(const GAS f32x4*)(sq + 4), s2 = *(const GAS f32x4*)(sq + 8), s3 = *(const GAS f32x4*)(sq + 12);
    const float ss = ((s0[0] + s0[1]) + (s0[2] + s0[3])) + ((s1[0] + s1[1]) + (s1[2] + s1[3])) + ((s2[0] + s2[1]) + (s2[2] + s2[3])) + ((s3[0] + s3[1]) + (s3[2] + s3[3]));
    const float r = 1.f / sqrtf(ss * (1.f / DM) + EPS);
#pragma unroll
    for (int j = 0; j < 4; ++j) { const f32x4 v = yr[64 * j], g = gr[64 * j]; yr[64 * j] = v * r * g; }
}

__global__ void __launch_bounds__(NWAVES * 64, 2) mega_fwd(Args args) {
    extern __shared__ __attribute__((aligned(16))) unsigned char lds_raw[];
    LAS unsigned char* lds = (LAS unsigned char*)lds_raw;
    volatile LAS unsigned* MISC = (volatile LAS unsigned*)(lds + MISC_OFF);
    const int tid = threadIdx.x, lane = tid & 63, wave = __builtin_amdgcn_readfirstlane(tid >> 6);
    const int G = gridDim.x, bx = blockIdx.x;
    gu32* ctl; { AP ap = args_ptr(); ctl = (gu32*)(ap->ws + WS_CTL); }
    for (int u = tid; u < (LDS_BYTES - MISC_OFF) / 4; u += NWAVES * 64) ((LAS unsigned*)(lds + MISC_OFF))[u] = 0u;
    __syncthreads();
    XcdBarrier bar; bar.bar = (unsigned*)(ctl + CW_BAR); bar.x = 0; bar.st = nullptr;
    if (N_LAUNCHES == 1) bar = xcd_barrier_post((unsigned*)(ctl + CW_BAR), MISC + 8);
#define GRID_BAR() do { if (N_LAUNCHES == 1) xcd_barrier(bar); } while (0)
    int lo, hi; { AP ap = args_ptr(); lo = ap->ph_lo; hi = ap->ph_hi; }
#define IN(k) (lo <= (k) && (k) < hi)
#define BOTH(k) (IN(k) && IN((k) + 1))
#ifndef PROBE_DUP
#define PROBE_DUP 0
#endif
#define REPS(k) (1 + ((PROBE_DUP >> (k)) & 1))

    if (IN(0)) { for (int rep = 0; rep < REPS(0); ++rep) { p0_prologue(args_ptr(), lds, wave, lane); if (BOTH(0) || rep + 1 < REPS(0)) GRID_BAR(); } }

    if (IN(1)) { for (int rep = 0; rep < REPS(1); ++rep) {
        AP ap = args_ptr(); unsigned char* ws = ap->ws;
        pg8::Gemm g{(const pg8::bf16_t*)(ws + WS_XN), (const pg8::bf16_t*)(ws + WS_WIN), M, INW, DM};
        pg8::StaticOrder S; S.init(M, INW, G, bx);
        pg8::EpiIn E{ws, ap->out};
        pg8::gemm_phase<pg8::EpiIn, pg8::StaticOrder, true, true>(lds, g, S, E);
        if (BOTH(1) || rep + 1 < REPS(1)) GRID_BAR();
    } }

    if (IN(2)) { for (int rep = 0; rep < REPS(2); ++rep) {
        AP ap = args_ptr();
        for (int u = bx; u < 528; u += G) attn_unit(ap, lds, u, tid, wave, lane);
        for (int cr = bx; cr < 256; cr += G) ssm_local_unit(ap, lds, cr, wave, lane);
        if (BOTH(2) || rep + 1 < REPS(2)) GRID_BAR();
    } }

    if (IN(3)) { for (int rep = 0; rep < REPS(3); ++rep) {
        AP ap = args_ptr();
        for (int cr = bx; cr < 264; cr += G) ssm_full_unit(ap, lds, cr, tid, wave, lane);
        if (BOTH(3) || rep + 1 < REPS(3)) GRID_BAR();
    } }

    if (IN(4)) { for (int rep = 0; rep < REPS(4); ++rep) {
        AP ap = args_ptr(); unsigned char* ws = ap->ws;
        pg8::Gemm g{(const pg8::bf16_t*)(ws + WS_AST), (const pg8::bf16_t*)(ws + WS_WST), 2 * M, 2048, 512};
        pg8::PairOrder S; S.base.init(MP, DM, G, bx); S.dM = M / 256; S.dN = 4;
        pg8::EpiMerge E{ws};
        pg8::gemm_phase<pg8::EpiMerge, pg8::PairOrder, true, true>(lds, g, S, E);
        for (int it = bx; it < 256; it += G) mini_merge(ap, lds, it, tid, wave, lane);
        if (BOTH(4) || rep + 1 < REPS(4)) GRID_BAR();
    } }

    if (IN(5)) { for (int rep = 0; rep < REPS(5); ++rep) {
        AP ap = args_ptr(); unsigned char* ws = ap->ws;
        pg8::Gemm g{(const pg8::bf16_t*)(ws + WS_XN), (const pg8::bf16_t*)(ws + WS_WOUT), MP, DM, DM};
        pg8::StaticOrder S; S.init(MP, DM, G, bx);
        pg8::EpiH1 E{ap->x_prompt, ap->x_sample, ap->out, ws};
        pg8::gemm_phase<pg8::EpiH1, pg8::StaticOrder, true, true>(lds, g, S, E);
        for (int it = bx; it < 256; it += G) mini_h1_pp(ap, lds, it, tid, wave, lane);
        if (BOTH(5) || rep + 1 < REPS(5)) GRID_BAR();
    } }

    if (IN(6)) {
        AP ap = args_ptr(); unsigned char* ws = ap->ws;
        {
            pg8::Gemm g{(const pg8::bf16_t*)(ws + WS_P), (const pg8::bf16_t*)(ws + WS_WPP), MP, DM, PLE};
            pg8::StaticOrder S; S.init(MP, DM, G, bx);
            pg8::EpiPP E{ws};
            pg8::gemm_phase<pg8::EpiPP, pg8::StaticOrder, true, true>(lds, g, S, E);
        }
        {
            pg8::Gemm g{(const pg8::bf16_t*)(ws + WS_GA), (const pg8::bf16_t*)(ws + WS_WPG), MP, DM, DM};
            pg8::StaticOrder S; S.init(MP, DM, G, bx);
            pg8::EpiH2 E{ap->out, ws};
            pg8::gemm_phase<pg8::EpiH2, pg8::StaticOrder, true, true>(lds, g, S, E);
        }
        for (int it = bx; it < 256; it += G) mini_h2(ap, lds, it, tid, wave, lane);
        if (BOTH(6)) GRID_BAR();
    }

    if (IN(7)) {
        const int gw = bx * NWAVES + wave, NGW = G * NWAVES;
        AP ap = args_ptr();
        for (int m = gw; m < M; m += NGW) final_norm_row(ap, m, lane);
    }
#undef IN
#undef BOTH
}

extern "C" void kernel_launch(void* const* d_in, const int* in_sizes, int n_in, void* d_out, int out_size, void* d_ws, size_t ws_size, hipStream_t stream) {
    static int grid = 0;
    if (grid == 0) {
        if (n_in != 26 || (size_t)out_size != OUT_TOTAL || ws_size < WS_END) { fprintf(stderr, "kernel_launch: unexpected shapes (n_in %d, out %d, ws %zu); nothing launched\n", n_in, out_size, ws_size); grid = -1; return; }
        int dev = 0, cus = 0, per_cu = 0;
        if (hipGetDevice(&dev) != hipSuccess || hipDeviceGetAttribute(&cus, hipDeviceAttributeMultiprocessorCount, dev) != hipSuccess) { grid = -1; return; }
        if (hipFuncSetAttribute((const void*)mega_fwd, hipFuncAttributeMaxDynamicSharedMemorySize, LDS_BYTES) != hipSuccess) { fprintf(stderr, "kernel_launch: hipFuncSetAttribute failed\n"); grid = -1; return; }
        if (hipOccupancyMaxActiveBlocksPerMultiprocessor(&per_cu, (const void*)mega_fwd, NWAVES * 64, LDS_BYTES) != hipSuccess || per_cu < 1) { fprintf(stderr, "kernel_launch: occupancy query says %d blocks per CU\n", per_cu); per_cu = 1; }
        (void)hipGetLastError();
        grid = cus;
    }
    if (grid < 0) return;
    if (hipMemsetAsync((char*)d_ws + WS_CTL, 0, CTL_ZERO_BYTES, stream) != hipSuccess) { fprintf(stderr, "kernel_launch: memset failed\n"); return; }
    Args a{};
    const float** pa = (const float**)&a;
    for (int i = 0; i < 26; ++i) pa[i] = (const float*)d_in[i];
    a.out = (float*)d_out; a.ws = (unsigned char*)d_ws;
    for (int li = 0; li < N_LAUNCHES; ++li) {
        a.ph_lo = (N_LAUNCHES == 1) ? 0 : li; a.ph_hi = (N_LAUNCHES == 1) ? N_PHASES : li + 1;
        hipLaunchKernelGGL(mega_fwd, dim3(grid), dim3(NWAVES * 64), LDS_BYTES, stream, a);
        const hipError_t le = hipPeekAtLastError();
        if (le != hipSuccess) { fprintf(stderr, "kernel_launch: launch %d failed: %s\n", li, hipGetErrorName(le)); break; }
    }
}
```

```cpp
#include <hip/hip_runtime.h>
#include <cstdio>
#include <cstdint>

typedef float f32x2_t __attribute__((ext_vector_type(2)));
typedef __bf16 bf16x2_t __attribute__((ext_vector_type(2)));
__device__ __forceinline__ unsigned cvtpk_s(float lo, float hi) { f32x2_t v = {lo, hi}; bf16x2_t b = __builtin_convertvector(v, bf16x2_t); return __builtin_bit_cast(unsigned, b); }
__device__ __forceinline__ float bf_lo(unsigned w) { return __uint_as_float(w << 16); }
__device__ __forceinline__ float bf_hi(unsigned w) { return __uint_as_float(w & 0xffff0000u); }
__device__ __forceinline__ float fast_exp(float x) { return __builtin_amdgcn_exp2f(x * 1.4426950408889634f); }
__device__ __forceinline__ float sigmoid_f(float x) { return __builtin_amdgcn_rcpf(1.0f + fast_exp(-x)); }
__device__ __forceinline__ float silu_f(float x) { return x * sigmoid_f(x); }
__device__ __forceinline__ float gelu_tanh_f(float x) { const float u = 1.5957691216057308f * (x + 0.044715f * x * x * x); return x * sigmoid_f(u); }

constexpr int DM = 1024, SEQ = 2048, NB = 8, DSEQ = 64, MP = NB * SEQ  , MS = NB * DSEQ  , M = MP + MS  ;
constexpr int INW = 4352, PLE = 256, PAST = 1024;
constexpr float EPS = 1e-6f;
constexpr size_t OFF_Y = 0, OFF_KP = (size_t)M * DM, OFF_VP = OFF_KP + 131072, OFF_SRP = OFF_VP + 131072, OFF_SIP = OFF_SRP + 16384,
                 OFF_KS = OFF_SIP + 16384, OFF_VS = OFF_KS + 131072, OFF_SRS = OFF_VS + 131072, OFF_SIS = OFF_SRS + 16384, OUT_TOTAL = OFF_SIS + 16384;

constexpr size_t MiB = 1u << 20;
constexpr size_t WS_CTL = 0, CTL_ZERO_BYTES = 1 * MiB;
constexpr size_t WS_WIN = 2 * MiB;
constexpr size_t WS_WST = 11 * MiB;
constexpr size_t WS_WGLU = 13 * MiB;
constexpr size_t WS_WOUT = 14 * MiB;
constexpr size_t WS_WPG = 16 * MiB;
constexpr size_t WS_WPP = 18 * MiB;
constexpr size_t WS_ROPE = 19 * MiB;
constexpr size_t WS_SSMB = 19 * MiB + 256 * 1024;
constexpr size_t WS_SSMC = 19 * MiB + 512 * 1024;
constexpr size_t WS_APOW = 19 * MiB + 768 * 1024;
constexpr size_t WS_SLOC = 20 * MiB;
constexpr size_t WS_SSQ = 24 * MiB;
constexpr size_t WS_XN = 32 * MiB;
constexpr size_t WS_P = 66 * MiB;
constexpr size_t WS_Q = 75 * MiB;
constexpr size_t WS_Z = WS_XN;
constexpr size_t WS_K = 92 * MiB;
constexpr size_t WS_V = 97 * MiB;
constexpr size_t WS_ZA = 102 * MiB;
constexpr size_t WS_U = 119 * MiB;
constexpr size_t WS_ZS = 136 * MiB;
constexpr size_t WS_GA = 153 * MiB;
constexpr size_t WS_GS = 186 * MiB;
constexpr size_t WS_AST = 219 * MiB;
constexpr size_t WS_END = 252 * MiB;
static_assert(WS_XN + (size_t)M * 1024 * 2 <= WS_P && WS_P + (size_t)M * 256 * 2 <= WS_Q && WS_Q + (size_t)M * 512 * 2 <= WS_K && WS_K + (size_t)M * 128 * 2 <= WS_V && WS_V + (size_t)M * 128 * 2 <= WS_ZA &&
              WS_ZA + (size_t)M * 512 * 2 <= WS_U && WS_U + (size_t)M * 512 * 2 <= WS_ZS && WS_ZS + (size_t)M * 512 * 2 <= WS_GA && WS_GA + (size_t)M * 1024 * 2 <= WS_GS && WS_GS + (size_t)M * 1024 * 2 <= WS_AST &&
              WS_AST + (size_t)2 * M * 512 * 2 <= WS_END && WS_WIN + (size_t)INW * 1024 * 2 <= WS_WST && WS_SSQ + (size_t)M * 16 * 4 <= WS_XN, "d_ws map");
constexpr int CW_TMO = 0, CW_BAR = 4096;

namespace pg8 {
#define PG8_LAS __attribute__((address_space(3)))
typedef unsigned short bf16_t;
typedef short bf16x8 __attribute__((ext_vector_type(8)));
typedef float f32x4 __attribute__((ext_vector_type(4)));
typedef unsigned u32x4 __attribute__((ext_vector_type(4)));
constexpr int BM = 256, BK = 64, HALF = 128, HTB = HALF * BK * 2  , STAGE_BYTES = 8 * HTB, NXCD = 8, WGM = 8;

__host__ __device__ __forceinline__ int lds_byte(int r, int c) { const int st = (r >> 4) * 2 + (c >> 5), rr = r & 15, cc = c & 31, ob = rr * 64 + cc * 2; return st * 1024 + (ob ^ (((ob >> 9) & 1) << 5)); }
__host__ __device__ __forceinline__ void stage_rc(int b, int& R, int& C) { const int st = b / 1024, sb = b % 1024, swz = sb ^ (((sb >> 9) & 1) << 5); R = (st >> 1) * 16 + swz / 64; C = (st & 1) * 32 + (swz % 64) / 2; }
__host__ __device__ __forceinline__ int perm32(int rho) { const int n = rho >> 4, i = rho & 15; return 8 * (i >> 2) + 4 * n + (i & 3); }

struct Unit { int pm, pn; };
struct Gemm { const bf16_t* A; const bf16_t* Bt; int M, N, K; };

struct StaticOrder {
    int nM, nN, nwg, G, c;
    __host__ __device__ void init(int M, int N, int G_, int c_) { nM = M / BM; nN = N / BM; nwg = nM * nN; G = G_; c = c_; }
    __host__ __device__ bool next(int i, Unit& u) const {
        const long L = (long)i * G + c; if (L >= nwg) return false;
        int wgid = (int)L; { const int q = nwg / NXCD, r = nwg % NXCD, xcd = wgid % NXCD, off = wgid / NXCD; wgid = (xcd < r ? xcd * (q + 1) : r * (q + 1) + (xcd - r) * q) + off; }
        const int nig = WGM * nN, gid = wgid / nig, fm = gid * WGM, gsz = (nM - fm) < WGM ? (nM - fm) : WGM;
        u.pm = fm + ((wgid % nig) % gsz); u.pn = (wgid % nig) / gsz; return true;
    }
    __device__ __forceinline__ void a_ready(const Unit&) const {}
    __device__ __forceinline__ void done(const Unit&) const {}
};


struct PairOrder {
    StaticOrder base; int dM, dN;
    __host__ __device__ bool next(int i, Unit& u) const { if (!base.next(i >> 1, u)) return false; if (i & 1) { u.pm += dM; u.pn += dN; } return true; }
    __device__ __forceinline__ void a_ready(const Unit&) const {}
    __device__ __forceinline__ void done(const Unit&) const {}
};

__device__ __forceinline__ u32x4 pack8(const f32x4 a, const f32x4 b) { u32x4 w; w.x = cvtpk_s(a[0], a[1]); w.y = cvtpk_s(a[2], a[3]); w.z = cvtpk_s(b[0], b[1]); w.w = cvtpk_s(b[2], b[3]); return w; }
__device__ __forceinline__ void unpack8(const u32x4 w, f32x4& a, f32x4& b) { a[0] = bf_lo(w.x); a[1] = bf_hi(w.x); a[2] = bf_lo(w.y); a[3] = bf_hi(w.y); b[0] = bf_lo(w.z); b[1] = bf_hi(w.z); b[2] = bf_lo(w.w); b[3] = bf_hi(w.w); }

struct EpiIn {
    static constexpr bool PERM = true, AFTER_DRAIN = false, CHAIN = false;
    unsigned char* ws; float* out;
    __device__ __forceinline__ void operator()(f32x4 (&acc)[2][2][4][2], const Unit& u, int wr, int wc, int fr, int fq) const {
        bf16_t* const Q = (bf16_t*)(ws + WS_Q); bf16_t* const Kb = (bf16_t*)(ws + WS_K); bf16_t* const Vb = (bf16_t*)(ws + WS_V); bf16_t* const ZA = (bf16_t*)(ws + WS_ZA);
        bf16_t* const U = (bf16_t*)(ws + WS_U); bf16_t* const ZS = (bf16_t*)(ws + WS_ZS); bf16_t* const GA = (bf16_t*)(ws + WS_GA); bf16_t* const GS = (bf16_t*)(ws + WS_GS);
        const float* const rope = (const float*)(ws + WS_ROPE);
        const int pn = u.pn;
        const int rowb = u.pm * BM + wr * 64 + fr;
        const int cw = wc * 32 + 8 * fq;
        bf16_t* dst; int ld, cbase, mode;
        if (pn < 2)       { dst = Q;  ld = 512;  cbase = pn * 256;        mode = 3; }
        else if (pn == 2) { dst = Kb; ld = 128;  cbase = 0;               mode = 4; }
        else if (pn < 5)  { dst = ZA; ld = 512;  cbase = (pn - 3) * 256;  mode = 1; }
        else if (pn < 7)  { dst = U;  ld = 512;  cbase = (pn - 5) * 256;  mode = 0; }
        else if (pn < 9)  { dst = ZS; ld = 512;  cbase = (pn - 7) * 256;  mode = 1; }
        else if (pn < 13) { dst = GA; ld = 1024; cbase = (pn - 9) * 256;  mode = 2; }
        else              { dst = GS; ld = 1024; cbase = (pn - 13) * 256; mode = 2; }
        const bool ropew = ((wc & 1) == 0);
#pragma unroll
        for (int ai = 0; ai < 2; ++ai)
#pragma unroll
            for (int m = 0; m < 4; ++m) {
                const int row = rowb + ai * HALF + m * 16;
                const int pos = row < MP ? (row & (SEQ - 1)) : PAST + ((row - MP) & (DSEQ - 1));
#pragma unroll
                for (int bj = 0; bj < 2; ++bj) {
                    f32x4 v0 = acc[ai][bj][m][0], v1 = acc[ai][bj][m][1];
                    if (mode == 1) {
#pragma unroll
                        for (int j = 0; j < 4; ++j) { v0[j] = silu_f(v0[j]); v1[j] = silu_f(v1[j]); }
                    } else if (mode == 2) {
#pragma unroll
                        for (int j = 0; j < 4; ++j) { v0[j] = sigmoid_f(v0[j]); v1[j] = sigmoid_f(v1[j]); }
                    } else if (mode == 3 || (mode == 4 && bj == 0)) {
                        if (ropew) {
                            f32x4 p0, p1;
#pragma unroll
                            for (int j = 0; j < 4; ++j) { p0[j] = __shfl_xor(v0[j], 16); p1[j] = __shfl_xor(v1[j], 16); }
                            if (fq < 2) {
                                const f32x4* cs = (const f32x4*)(rope + (size_t)pos * 16);
                                const f32x4 c01 = cs[0], c23 = cs[1], c45 = cs[2], c67 = cs[3];
                                const float sg = fq == 0 ? -1.f : 1.f;
                                v0[0] = v0[0] * c01[0] + sg * p0[0] * c01[1]; v0[1] = v0[1] * c01[2] + sg * p0[1] * c01[3];
                                v0[2] = v0[2] * c23[0] + sg * p0[2] * c23[1]; v0[3] = v0[3] * c23[2] + sg * p0[3] * c23[3];
                                v1[0] = v1[0] * c45[0] + sg * p1[0] * c45[1]; v1[1] = v1[1] * c45[2] + sg * p1[1] * c45[3];
                                v1[2] = v1[2] * c67[0] + sg * p1[2] * c67[1]; v1[3] = v1[3] * c67[2] + sg * p1[3] * c67[3];
                            }
                        }
                    }
                    if (mode == 4) {
                        bf16_t* d2 = bj == 0 ? Kb : Vb;
                        *(u32x4*)(d2 + (size_t)row * 128 + cw) = pack8(v0, v1);
                        float* w = nullptr;
                        if (u.pm >= MP / BM) { const int rs = row - MP; w = out + (bj == 0 ? OFF_KS : OFF_VS) + ((size_t)((rs >> 6) * 128 + 64 + (rs & 63))) * 128 + cw; }
                        else if ((u.pm & 7) == 7 && ai == 1) { const int t = row & (SEQ - 1); w = out + (bj == 0 ? OFF_KP : OFF_VP) + ((size_t)((row >> 11) * 128 + (t - (SEQ - 128)))) * 128 + cw; }
                        if (w) { *(f32x4*)w = v0; *(f32x4*)(w + 4) = v1; }
                    } else {
                        *(u32x4*)(dst + (size_t)row * ld + cbase + bj * HALF + cw) = pack8(v0, v1);
                    }
                }
            }
    }
};

struct EpiMerge {
    static constexpr bool PERM = true, AFTER_DRAIN = false, CHAIN = true;
    unsigned char* ws;
    static constexpr int nMt = M / BM;
    __device__ __forceinline__ void operator()(f32x4 (&acc)[2][2][4][2], const Unit& u, int wr, int wc, int fr, int fq) const {
        const bf16_t* const GA = (const bf16_t*)(ws + WS_GA); const bf16_t* const GS = (const bf16_t*)(ws + WS_GS); bf16_t* const MG = (bf16_t*)(ws + WS_XN);
        const bool second = u.pn >= 4;
        const int pm = second ? u.pm - nMt : u.pm, pn = second ? u.pn - 4 : u.pn;
        const int rowb = pm * BM + wr * 64 + fr, colb = pn * BM + wc * 32 + 8 * fq;
#pragma unroll
        for (int ai = 0; ai < 2; ++ai)
#pragma unroll
            for (int m = 0; m < 4; ++m) {
                const size_t ro = (size_t)(rowb + ai * HALF + m * 16) * DM + colb;
#pragma unroll
                for (int bj = 0; bj < 2; ++bj) {
                    f32x4 s0, s1; unpack8(*(const u32x4*)(GS + ro + bj * HALF), s0, s1);
                    if (!second) {
                        f32x4 a0, a1; unpack8(*(const u32x4*)(GA + ro + bj * HALF), a0, a1);
#pragma unroll
                        for (int j = 0; j < 4; ++j) { acc[ai][bj][m][0][j] *= a0[j] * __builtin_amdgcn_rcpf(s0[j]); acc[ai][bj][m][1][j] *= a1[j] * __builtin_amdgcn_rcpf(s1[j]); }
                    } else {
                        *(u32x4*)(MG + ro + bj * HALF) = pack8(acc[ai][bj][m][0] * s0, acc[ai][bj][m][1] * s1);
                    }
                }
                asm volatile("" ::: "memory");
            }
    }
};

struct EpiH1 {
    static constexpr bool PERM = true, AFTER_DRAIN = false, CHAIN = false;
    const float *xp, *xs; float* out; unsigned char* ws;
    __device__ __forceinline__ void operator()(f32x4 (&acc)[2][2][4][2], const Unit& u, int wr, int wc, int fr, int fq) const {
        bf16_t* const H1B = (bf16_t*)(ws + WS_GA);
        const int rowb = u.pm * BM + wr * 64 + fr, colb = u.pn * BM + wc * 32 + 8 * fq;
        const float* xb = u.pm < MP / BM ? xp : xs - (size_t)MP * DM;
#pragma unroll
        for (int ai = 0; ai < 2; ++ai)
#pragma unroll
            for (int m = 0; m < 4; ++m) {
                const size_t ro = (size_t)(rowb + ai * HALF + m * 16) * DM + colb;
#pragma unroll
                for (int bj = 0; bj < 2; ++bj) {
                    const f32x4 h0 = *(const f32x4*)(xb + ro + bj * HALF) + acc[ai][bj][m][0], h1 = *(const f32x4*)(xb + ro + bj * HALF + 4) + acc[ai][bj][m][1];
                    *(f32x4*)(out + ro + bj * HALF) = h0; *(f32x4*)(out + ro + bj * HALF + 4) = h1;
                    *(u32x4*)(H1B + ro + bj * HALF) = pack8(h0, h1);
                }
                asm volatile("" ::: "memory");
            }
    }
};

struct EpiPP {
    static constexpr bool PERM = true, AFTER_DRAIN = false, CHAIN = false;
    unsigned char* ws;
    __device__ __forceinline__ void operator()(f32x4 (&acc)[2][2][4][2], const Unit& u, int wr, int wc, int fr, int fq) const {
        bf16_t* const PP = (bf16_t*)(ws + WS_GS);
        const int rowb = u.pm * BM + wr * 64 + fr, colb = u.pn * BM + wc * 32 + 8 * fq;
#pragma unroll
        for (int ai = 0; ai < 2; ++ai)
#pragma unroll
            for (int m = 0; m < 4; ++m) {
                const size_t ro = (size_t)(rowb + ai * HALF + m * 16) * DM + colb;
#pragma unroll
                for (int bj = 0; bj < 2; ++bj) *(u32x4*)(PP + ro + bj * HALF) = pack8(acc[ai][bj][m][0], acc[ai][bj][m][1]);
            }
    }
};

struct EpiH2 {
    static constexpr bool PERM = true, AFTER_DRAIN = false, CHAIN = false;
    float* out; unsigned char* ws;
    __device__ __forceinline__ void operator()(f32x4 (&acc)[2][2][4][2], const Unit& u, int wr, int wc, int fr, int fq) const {
        const bf16_t* const PP = (const bf16_t*)(ws + WS_GS); float* const ssq = (float*)(ws + WS_SSQ);
        const int rowb = u.pm * BM + wr * 64 + fr, colb = u.pn * BM + wc * 32 + 8 * fq;
#pragma unroll
        for (int ai = 0; ai < 2; ++ai)
#pragma unroll
            for (int m = 0; m < 4; ++m) {
                const int row = rowb + ai * HALF + m * 16;
                const size_t ro = (size_t)row * DM + colb;
                float sq = 0.f;
#pragma unroll
                for (int bj = 0; bj < 2; ++bj) {
                    f32x4 p0, p1; unpack8(*(const u32x4*)(PP + ro + bj * HALF), p0, p1);
                    f32x4 h0 = *(const f32x4*)(out + ro + bj * HALF), h1 = *(const f32x4*)(out + ro + bj * HALF + 4);
#pragma unroll
                    for (int j = 0; j < 4; ++j) { h0[j] += sigmoid_f(acc[ai][bj][m][0][j]) * p0[j]; h1[j] += sigmoid_f(acc[ai][bj][m][1][j]) * p1[j]; sq += h0[j] * h0[j] + h1[j] * h1[j]; }
                    *(f32x4*)(out + ro + bj * HALF) = h0; *(f32x4*)(out + ro + bj * HALF + 4) = h1;
                }
                sq += __shfl_xor(sq, 16); sq += __shfl_xor(sq, 32);
                if (fq == 0) ssq[(size_t)row * 16 + u.pn * 4 + wc] = sq;
                asm volatile("" ::: "memory");
            }
    }
};


struct EpiGLU {
    static constexpr bool PERM = true, AFTER_DRAIN = false, CHAIN = false;
    unsigned char* ws;
    __device__ __forceinline__ void operator()(f32x4 (&acc)[2][2][4][2], const Unit& u, int wr, int wc, int fr, int fq) const {
        const bf16_t* const Z = (const bf16_t*)(ws + WS_Z); const bf16_t* const ZS = (const bf16_t*)(ws + WS_ZS); bf16_t* const S1 = (bf16_t*)(ws + WS_AST) + (size_t)M * 512;
        const int rowb = u.pm * BM + wr * 64 + fr, colb = u.pn * BM + wc * 32 + 8 * fq;
#pragma unroll
        for (int ai = 0; ai < 2; ++ai)
#pragma unroll
            for (int m = 0; m < 4; ++m) {
                const size_t ro = (size_t)(rowb + ai * HALF + m * 16) * 512 + colb;
#pragma unroll
                for (int bj = 0; bj < 2; ++bj) {
                    f32x4 z0, z1, s0, s1; unpack8(*(const u32x4*)(Z + ro + bj * HALF), z0, z1); unpack8(*(const u32x4*)(ZS + ro + bj * HALF), s0, s1);
#pragma unroll
                    for (int j = 0; j < 4; ++j) { z0[j] *= sigmoid_f(acc[ai][bj][m][0][j]) * s0[j]; z1[j] *= sigmoid_f(acc[ai][bj][m][1][j]) * s1[j]; }
                    *(u32x4*)(S1 + ro + bj * HALF) = pack8(z0, z1);
                }
                asm volatile("" ::: "memory");
            }
    }
};
template <class Epi, class Sched, bool ALIGN_EPI = false, bool SP2 = false>
__device__ __forceinline__ void gemm_phase(PG8_LAS unsigned char* lds, const Gemm g, const Sched& S, const Epi& E) {
    int tid = threadIdx.x; asm volatile("" : "+v"(tid));
    const int wid = __builtin_amdgcn_readfirstlane(tid >> 6), lane = tid & 63, wr = wid >> 2, wc = wid & 3, fr = lane & 15, fq = lane >> 4;
    int K = g.K; asm volatile("" : "+s"(K));
    const int nt = K / BK;
    unsigned voffA[2], voffB[2];
#pragma unroll
    for (int i = 0; i < 2; ++i) { int R, C; stage_rc(tid * 16 + i * 8192, R, C); const int Rb = Epi::PERM ? ((R & ~31) + perm32(R & 31)) : R;
        voffA[i] = (unsigned)(R * K + C) * 2u; voffB[i] = (unsigned)(Rb * K + C) * 2u; }
    const size_t kstep = (size_t)(BK * 2);
    const size_t hstep = (size_t)HALF * K * 2;
    const size_t tstep = 2 * hstep;
    const unsigned ldsw = (unsigned)wid * 1024u;
    const int aoff = lds_byte(wr * 64 + fr, fq * 8), boff = lds_byte(wc * 32 + fr, fq * 8);
#define PG8_SA(b, h) (((b) * 2 + (h)) * HTB)
#define PG8_SB(b, h) ((4 + (b) * 2 + (h)) * HTB)
#define PG8_STAGE(bufoff, gbase, voff) do { _Pragma("unroll") for (int _i = 0; _i < 2; ++_i) \
        __builtin_amdgcn_global_load_lds((const unsigned*)((const char*)(gbase) + (voff)[_i]), (PG8_LAS unsigned*)(lds + (bufoff) + ldsw + _i * 8192), 16, 0, 0); } while (0)
#define PG8_LDA(dst, b, h) do { _Pragma("unroll") for (int m = 0; m < 4; ++m) _Pragma("unroll") for (int k = 0; k < 2; ++k) dst[m][k] = *(const PG8_LAS bf16x8*)(lds + PG8_SA(b, h) + aoff + m * 2048 + k * 1024); } while (0)
#define PG8_LDB(dst, b, h) do { _Pragma("unroll") for (int n = 0; n < 2; ++n) _Pragma("unroll") for (int k = 0; k < 2; ++k) dst[n][k] = *(const PG8_LAS bf16x8*)(lds + PG8_SB(b, h) + boff + n * 2048 + k * 1024); } while (0)
#define PG8_MMA(ai, bj, At, Bt) do { __builtin_amdgcn_s_setprio(1); _Pragma("unroll") for (int m = 0; m < 4; ++m) _Pragma("unroll") for (int n = 0; n < 2; ++n) _Pragma("unroll") for (int k = 0; k < 2; ++k) \
        acc[ai][bj][m][n] = __builtin_amdgcn_mfma_f32_16x16x32_bf16(Bt[n][k], At[m][k], acc[ai][bj][m][n], 0, 0, 0); __builtin_amdgcn_s_setprio(0); } while (0)
#define PG8_WAIT_V(n) asm volatile("s_waitcnt vmcnt(" #n ")" ::: "memory")
#define PG8_WAIT_L(n) asm volatile("s_waitcnt lgkmcnt(" #n ")" ::: "memory")
#define PG8_BAR __builtin_amdgcn_s_barrier()
#define PG8_SCHED __builtin_amdgcn_sched_barrier(0)
    Unit cur, nxt; int ui = 0;
    if (!S.next(0, cur)) return;
    f32x4 acc[2][2][4][2];
#pragma unroll
    for (int a = 0; a < 2; ++a)
#pragma unroll
        for (int b = 0; b < 2; ++b)
#pragma unroll
            for (int m = 0; m < 4; ++m)
#pragma unroll
                for (int n = 0; n < 2; ++n) acc[a][b][m][n] = (f32x4){0.f, 0.f, 0.f, 0.f};
    bf16x8 At[4][2], B0[2][2], B1[2][2];
    const char* cA = (const char*)g.A + (size_t)cur.pm * tstep; const char* cB = (const char*)g.Bt + (size_t)cur.pn * tstep;
    S.a_ready(cur);
    if constexpr (SP2) {
        PG8_STAGE(PG8_SB(0, 0), cB, voffB); PG8_STAGE(PG8_SB(0, 1), cB + hstep, voffB); PG8_STAGE(PG8_SA(0, 0), cA, voffA); PG8_STAGE(PG8_SA(0, 1), cA + hstep, voffA);
        if (wr == 1) PG8_BAR;
        PG8_WAIT_V(2); PG8_BAR;
        PG8_STAGE(PG8_SB(1, 0), cB + kstep, voffB); PG8_STAGE(PG8_SA(1, 0), cA + kstep, voffA); PG8_STAGE(PG8_SB(1, 1), cB + hstep + kstep, voffB);
        PG8_WAIT_V(6); PG8_BAR;
    } else {
        PG8_STAGE(PG8_SB(0, 0), cB, voffB); PG8_STAGE(PG8_SA(0, 0), cA, voffA); PG8_STAGE(PG8_SB(0, 1), cB + hstep, voffB); PG8_STAGE(PG8_SA(0, 1), cA + hstep, voffA);
        if (wr == 1) PG8_BAR;
        PG8_WAIT_V(4); PG8_BAR;
        PG8_STAGE(PG8_SB(1, 0), cB + kstep, voffB); PG8_STAGE(PG8_SA(1, 0), cA + kstep, voffA); PG8_STAGE(PG8_SB(1, 1), cB + hstep + kstep, voffB);
        PG8_WAIT_V(6); PG8_BAR;
    }
    for (;;) {
        const bool has_next = S.next(ui + 1, nxt);
        const char* nA = has_next ? (const char*)g.A + (size_t)nxt.pm * tstep : cA; const char* nB = has_next ? (const char*)g.Bt + (size_t)nxt.pn * tstep : cB;
        for (int t = 0; t < nt; t += 2) {
            const bool last = (t == nt - 2);
            const char* a1 = cA + (size_t)(t + 1) * kstep;
            const char* a2 = last ? nA : cA + (size_t)(t + 2) * kstep; const char* b2 = last ? nB : cB + (size_t)(t + 2) * kstep;
            const char* a3 = a2 + kstep; const char* b3 = b2 + kstep;
            if (last && has_next) S.a_ready(nxt);
            if constexpr (SP2) {
            PG8_LDB(B0, 0, 0); PG8_LDB(B1, 0, 1); PG8_SCHED; PG8_LDA(At, 0, 0); PG8_STAGE(PG8_SA(1, 1), a1 + hstep, voffA);
            PG8_WAIT_V(8); PG8_WAIT_L(0); PG8_BAR; PG8_MMA(0, 0, At, B0); PG8_MMA(0, 1, At, B1); PG8_BAR; PG8_SCHED;
            PG8_LDA(At, 0, 1); PG8_STAGE(PG8_SB(0, 0), b2, voffB); PG8_STAGE(PG8_SB(0, 1), b2 + hstep, voffB); PG8_STAGE(PG8_SA(0, 0), a2, voffA);
            PG8_WAIT_V(8); PG8_WAIT_L(0); PG8_BAR; PG8_MMA(1, 0, At, B0); PG8_MMA(1, 1, At, B1); PG8_BAR; PG8_SCHED;
            PG8_LDB(B0, 1, 0); PG8_LDB(B1, 1, 1); PG8_SCHED; PG8_LDA(At, 1, 0); PG8_STAGE(PG8_SA(0, 1), a2 + hstep, voffA);
            PG8_WAIT_V(8); PG8_WAIT_L(0); PG8_BAR; PG8_MMA(0, 0, At, B0); PG8_MMA(0, 1, At, B1); PG8_BAR; PG8_SCHED;
            PG8_LDA(At, 1, 1); PG8_STAGE(PG8_SB(1, 0), b3, voffB); PG8_STAGE(PG8_SB(1, 1), b3 + hstep, voffB); PG8_STAGE(PG8_SA(1, 0), a3, voffA);
            PG8_WAIT_V(8); PG8_WAIT_L(0); PG8_BAR; PG8_MMA(1, 0, At, B0); PG8_MMA(1, 1, At, B1); PG8_BAR; PG8_SCHED;
            } else {
            PG8_LDB(B0, 0, 0); PG8_SCHED; PG8_LDA(At, 0, 0); PG8_STAGE(PG8_SA(1, 1), a1 + hstep, voffA);
            PG8_WAIT_L(8); PG8_BAR; PG8_WAIT_L(0); PG8_MMA(0, 0, At, B0); PG8_BAR; PG8_SCHED;
            PG8_LDB(B1, 0, 1); PG8_STAGE(PG8_SB(0, 0), b2, voffB);
            PG8_BAR; PG8_WAIT_L(0); PG8_MMA(0, 1, At, B1); PG8_BAR;
            PG8_LDA(At, 0, 1); PG8_STAGE(PG8_SA(0, 0), a2, voffA);
            PG8_BAR; PG8_WAIT_L(0); PG8_MMA(1, 0, At, B0); PG8_BAR; PG8_SCHED;
            PG8_STAGE(PG8_SB(0, 1), b2 + hstep, voffB);
            PG8_WAIT_V(6); PG8_BAR; PG8_MMA(1, 1, At, B1); PG8_BAR;
            PG8_LDB(B0, 1, 0); PG8_SCHED; PG8_LDA(At, 1, 0); PG8_STAGE(PG8_SA(0, 1), a2 + hstep, voffA);
            PG8_WAIT_L(8); PG8_BAR; PG8_WAIT_L(0); PG8_MMA(0, 0, At, B0); PG8_BAR; PG8_SCHED;
            PG8_LDB(B1, 1, 1); PG8_STAGE(PG8_SB(1, 0), b3, voffB);
            PG8_BAR; PG8_WAIT_L(0); PG8_MMA(0, 1, At, B1); PG8_BAR;
            PG8_LDA(At, 1, 1); PG8_STAGE(PG8_SA(1, 0), a3, voffA);
            PG8_BAR; PG8_WAIT_L(0); PG8_MMA(1, 0, At, B0); PG8_BAR; PG8_SCHED;
            PG8_STAGE(PG8_SB(1, 1), b3 + hstep, voffB);
            PG8_WAIT_V(6); PG8_BAR; PG8_MMA(1, 1, At, B1); PG8_BAR;
            }
        }
        if constexpr (ALIGN_EPI) { if (wr == 0) PG8_BAR; }
        if constexpr (!Epi::AFTER_DRAIN) { E(acc, cur, wr, wc, fr, fq); S.done(cur); }
        if (!has_next) break;
        if (!(Epi::CHAIN && (ui & 1) == 0)) {
#pragma unroll
        for (int a = 0; a < 2; ++a)
#pragma unroll
            for (int b = 0; b < 2; ++b)
#pragma unroll
                for (int m = 0; m < 4; ++m)
#pragma unroll
                    for (int n = 0; n < 2; ++n) acc[a][b][m][n] = (f32x4){0.f, 0.f, 0.f, 0.f};
        }
        cur = nxt; cA = nA; cB = nB; ++ui;
        if constexpr (ALIGN_EPI) { if (wr == 1) PG8_BAR; }
    }
    PG8_WAIT_V(0);
    if constexpr (!ALIGN_EPI) { if (wr == 0) PG8_BAR; }
    PG8_BAR;
    if constexpr (Epi::AFTER_DRAIN) { E.fused(acc, cur, wr, wc, fr, fq, lds, wid, lane); S.done(cur); }
#undef PG8_SA
#undef PG8_SB
#undef PG8_STAGE
#undef PG8_LDA
#undef PG8_LDB
#undef PG8_MMA
#undef PG8_WAIT_V
#undef PG8_WAIT_L
#undef PG8_BAR
#undef PG8_SCHED
}
}


constexpr int NWAVES = 8;
#ifndef MK_N_LAUNCHES
#define MK_N_LAUNCHES 1
#endif
constexpr int N_PHASES = 9;
constexpr int N_LAUNCHES = MK_N_LAUNCHES;

constexpr int RING_BYTES = 131072;
constexpr int KL_STRIDE = 144, VT_STRIDE = 400;
constexpr int LDS_KL = 0, LDS_VT = 192 * KL_STRIDE;
constexpr int ZL_STRIDE = 1040, HL_STRIDE = 272;
constexpr int LDS_ZL = 0, LDS_HL = 64 * ZL_STRIDE  , HL_WAVE = 32 * HL_STRIDE  , LDS_HP = LDS_HL + NWAVES * HL_WAVE  , LDS_P3_END = LDS_HP + 16384  ;
constexpr int MISC_OFF = LDS_P3_END;
constexpr int LDS_BYTES = 153600;
static_assert(MISC_OFF + 512 <= LDS_BYTES && LDS_VT + 64 * VT_STRIDE <= RING_BYTES, "LDS map");

#define GAS __attribute__((address_space(1)))
#define LAS __attribute__((address_space(3)))
typedef unsigned short bf16;
typedef unsigned v4u __attribute__((ext_vector_type(4)));
typedef unsigned v2u __attribute__((ext_vector_type(2)));
typedef float f32x4 __attribute__((ext_vector_type(4)));
typedef float f32x16 __attribute__((ext_vector_type(16)));
typedef short bf16x8 __attribute__((ext_vector_type(8)));
typedef GAS unsigned gu32;
#define RLX_AGENT __ATOMIC_RELAXED, __HIP_MEMORY_SCOPE_AGENT
#define LDS_WAIT() asm volatile("s_waitcnt lgkmcnt(0)" ::: "memory")
#define VM_WAIT() asm volatile("s_waitcnt vmcnt(0)" ::: "memory")
__device__ __forceinline__ unsigned pk2(float lo, float hi) { return cvtpk_s(lo, hi); }
__device__ __forceinline__ bf16 f2bf(float f) { return (bf16)(cvtpk_s(f, 0.f) & 0xffffu); }

#define XB_TMO      128
#define XB_XCNT(j)  (256  + 64 * (j))
#define XB_XSUB(j)  (1280 + 64 * (j))
#define XB_XGEN(j)  (2304 + 64 * (j))
#define XB_TOP      3328
#define XB_TOPGEN   3392
#define XCD_BAR_WORDS 3456
#define XB_SPIN_CAP (1u << 18)

__device__ __forceinline__ unsigned xb_ld(unsigned* p)              { return __hip_atomic_load(p, __ATOMIC_RELAXED, __HIP_MEMORY_SCOPE_AGENT); }
__device__ __forceinline__ unsigned xb_add(unsigned* p, unsigned v) { return __hip_atomic_fetch_add(p, v, __ATOMIC_RELAXED, __HIP_MEMORY_SCOPE_AGENT); }
__device__ __forceinline__ unsigned xb_xcc_id() { return (unsigned)__builtin_amdgcn_s_getreg((3 << 11) | 20) & 0xFu; }
#define XB_SPIN(cond, bar) do { unsigned _sp = 0; while (cond) { __builtin_amdgcn_s_sleep(1); \
    if ((++_sp & 255u) == 0u) { if (xb_ld(&(bar)[XB_TMO])) break; if (_sp > XB_SPIN_CAP) { atomicAdd(&(bar)[XB_TMO], 1u); break; } } } } while (0)

struct XcdBarrier { unsigned* bar; unsigned x; volatile LAS unsigned* st; };

__device__ __forceinline__ XcdBarrier xcd_barrier_post(unsigned* bar, volatile LAS unsigned* st) {
    XcdBarrier b; b.bar = bar; b.x = xb_xcc_id(); b.st = st;
    if (threadIdx.x == 0) (void)xb_add(&bar[XB_XCNT(b.x)], 1u);
    return b;
}
__device__ __forceinline__ void xcd_barrier_complete(unsigned* bar, unsigned x, unsigned& nloc, unsigned& nx) {
    const unsigned G = gridDim.x * gridDim.y * gridDim.z;
    unsigned sum, cnt, mine, sp = 0u;
    for (;;) {
        sum = 0u; cnt = 0u; mine = 0u;
#pragma unroll
        for (unsigned j = 0; j < 16; ++j) { const unsigned c = xb_ld(&bar[XB_XCNT(j)]); sum += c; cnt += (c > 0u) ? 1u : 0u; mine = (j == x) ? c : mine; }
        if (sum == G) break;
        __builtin_amdgcn_s_sleep(1);
        if ((++sp & 255u) == 0u) { if (xb_ld(&bar[XB_TMO])) break; if (sp > XB_SPIN_CAP) { atomicAdd(&bar[XB_TMO], 1u); break; } }
    }
    nloc = mine > 0u ? mine : 1u; nx = cnt > 0u ? cnt : 1u;
}
__device__ __forceinline__ void xcd_barrier(const XcdBarrier& b) {
    asm volatile("s_waitcnt vmcnt(0)" ::: "memory");
    __syncthreads();
    if (threadIdx.x == 0) {
        unsigned* bar = b.bar;
        __builtin_amdgcn_s_waitcnt(0);
        unsigned nloc = b.st[0], nx = b.st[1];
        if (nloc == 0u) { xcd_barrier_complete(bar, b.x, nloc, nx); b.st[0] = nloc; b.st[1] = nx; }
        const unsigned old = xb_add(&bar[XB_XSUB(b.x)], 1u);
        const unsigned gen = old / nloc;
        if (old + 1u == (gen + 1u) * nloc) {
            __builtin_amdgcn_fence(__ATOMIC_RELEASE, "agent");
            asm volatile("s_waitcnt vmcnt(0)" ::: "memory");
            const unsigned og = xb_add(&bar[XB_TOP], 1u);
            const unsigned tg = og / nx;
            if (og + 1u == (tg + 1u) * nx) xb_add(&bar[XB_TOPGEN], 1u);
            else XB_SPIN(xb_ld(&bar[XB_TOPGEN]) == tg, bar);
            __builtin_amdgcn_fence(__ATOMIC_ACQUIRE, "agent");
            xb_add(&bar[XB_XGEN(b.x)], 1u);
            asm volatile("s_waitcnt vmcnt(0)" ::: "memory");
        } else {
            XB_SPIN(xb_ld(&bar[XB_XGEN(b.x)]) == gen, bar);
            __builtin_amdgcn_fence(__ATOMIC_ACQUIRE, "agent");
            asm volatile("s_waitcnt vmcnt(0)" ::: "memory");
        }
    }
    __syncthreads();
}

struct Args {
    const float *x_prompt, *x_sample, *p_prompt, *p_sample, *cache_k, *cache_v, *st_re, *st_im, *norm_gain, *w_in, *sinks, *w_o_attn,
                *a_re, *a_im, *log_dt, *b_re, *b_im, *c_re, *c_im, *ssm_d, *w_glu, *w_o_ssm, *w_out, *w_pg, *w_pp, *fgain;
    float* out; unsigned char* ws; int ph_lo, ph_hi;
};
typedef const __attribute__((address_space(4))) Args* AP;
__device__ __forceinline__ AP args_ptr() { AP p = (AP)__builtin_amdgcn_kernarg_segment_ptr(); asm volatile("" : "+s"(p)); return p; }

__device__ __forceinline__ float wave_sum(float v) {
#pragma unroll
    for (int o = 1; o < 64; o <<= 1) v += __shfl_xor(v, o);
    return v;
}
__device__ __forceinline__ void p0_transpose_item(const float* W, int K, int N, bf16* WT, int row_off, LAS float* scr, int item, int lane) {
    const int nblk = N / 32, kb = item / nblk, nb = item % nblk, k0 = 64 * kb, n0 = 32 * nb;
    float wv[32];
#pragma unroll
    for (int i = 0; i < 32; ++i) wv[i] = W[(size_t)(k0 + 2 * i + (lane >> 5)) * N + n0 + (lane & 31)];
#pragma unroll
    for (int i = 0; i < 32; ++i) scr[(2 * i + (lane >> 5)) * 33 + (lane & 31)] = wv[i];
    LDS_WAIT(); asm volatile("" ::: "memory");
    const int c = lane & 7;
#pragma unroll
    for (int j = 0; j < 4; ++j) { const int n = (lane >> 3) + 8 * j; const LAS float* s = scr + (8 * c) * 33 + n;
        v4u o; o.x = pk2(s[0 * 33], s[1 * 33]); o.y = pk2(s[2 * 33], s[3 * 33]); o.z = pk2(s[4 * 33], s[5 * 33]); o.w = pk2(s[6 * 33], s[7 * 33]);
        *(GAS v4u*)(WT + (size_t)(row_off + n0 + n) * K + k0 + 8 * c) = o; }
    LDS_WAIT(); asm volatile("" ::: "memory");
}
__device__ __forceinline__ void rms_row_to_bf16(const float* xrow, const float* gain, bf16* orow, int lane) {
    const GAS f32x4* xr = (const GAS f32x4*)xrow + lane; const GAS f32x4* gr = (const GAS f32x4*)gain + lane;
    f32x4 v[4]; float s = 0.f;
#pragma unroll
    for (int j = 0; j < 4; ++j) { v[j] = xr[64 * j]; s += (v[j].x * v[j].x + v[j].y * v[j].y) + (v[j].z * v[j].z + v[j].w * v[j].w); }
    const float r = 1.f / sqrtf(wave_sum(s) * (1.f / DM) + EPS);
    GAS v2u* o8 = (GAS v2u*)orow + lane;
#pragma unroll
    for (int j = 0; j < 4; ++j) { const f32x4 g = gr[64 * j]; v2u o; o.x = pk2(v[j].x * r * g.x, v[j].y * r * g.y); o.y = pk2(v[j].z * r * g.z, v[j].w * r * g.w); o8[64 * j] = o; }
}
__device__ __forceinline__ void sincos_d(double x, double& s, double& c) {
    const double k = __builtin_rint(x * 0.63661977236758134);
    double r = __builtin_fma(-k, 1.5707963267948966, x); r = __builtin_fma(-k, 6.123233995736766e-17, r);
    const int q = ((int)k) & 3;
    const double r2 = r * r;
    double sp = 1.0 / 355687428096000.0;
    sp = sp * r2 - 1.0 / 1307674368000.0; sp = sp * r2 + 1.0 / 6227020800.0; sp = sp * r2 - 1.0 / 39916800.0; sp = sp * r2 + 1.0 / 362880.0;
    sp = sp * r2 - 1.0 / 5040.0; sp = sp * r2 + 1.0 / 120.0; sp = sp * r2 - 1.0 / 6.0; sp = sp * r2 + 1.0; sp = sp * r;
    double cp = 1.0 / 20922789888000.0;
    cp = cp * r2 - 1.0 / 87178291200.0; cp = cp * r2 + 1.0 / 479001600.0; cp = cp * r2 - 1.0 / 3628800.0; cp = cp * r2 + 1.0 / 40320.0;
    cp = cp * r2 - 1.0 / 720.0; cp = cp * r2 + 1.0 / 24.0; cp = cp * r2 - 0.5; cp = cp * r2 + 1.0;
    s = (q == 0) ? sp : (q == 1) ? cp : (q == 2) ? -sp : -cp;
    c = (q == 0) ? cp : (q == 1) ? -sp : (q == 2) ? -cp : sp;
}
__device__ __forceinline__ double exp_d(double x) {
    const double k = __builtin_rint(x * 1.4426950408889634);
    double r = __builtin_fma(-k, 0.6931471805599453, x); r = __builtin_fma(-k, 2.3190468138462996e-17, r);
    double p = 1.0 / 6227020800.0;
    p = p * r + 1.0 / 479001600.0; p = p * r + 1.0 / 39916800.0; p = p * r + 1.0 / 3628800.0; p = p * r + 1.0 / 362880.0; p = p * r + 1.0 / 40320.0; p = p * r + 1.0 / 5040.0;
    p = p * r + 1.0 / 720.0; p = p * r + 1.0 / 120.0; p = p * r + 1.0 / 24.0; p = p * r + 1.0 / 6.0; p = p * r + 0.5; p = p * r + 1.0; p = p * r + 1.0;
    const long long bits = (long long)(1023 + (int)k) << 52;
    return p * __builtin_bit_cast(double, bits);
}
__device__ __forceinline__ double expm1_small_d(double x) {
    double p = 1.0 / 479001600.0;
    p = p * x + 1.0 / 39916800.0; p = p * x + 1.0 / 3628800.0; p = p * x + 1.0 / 362880.0; p = p * x + 1.0 / 40320.0; p = p * x + 1.0 / 5040.0;
    p = p * x + 1.0 / 720.0; p = p * x + 1.0 / 120.0; p = p * x + 1.0 / 24.0; p = p * x + 1.0 / 6.0; p = p * x + 0.5; p = p * x + 1.0;
    return p * x;
}

__device__ __forceinline__ void p0_prologue(AP a, LAS unsigned char* lds, int wave, int lane) {
    unsigned char* ws = a->ws;
    LAS float* scr = (LAS float*)(lds + wave * 16384);
    const int gw = blockIdx.x * NWAVES + wave, NGW = gridDim.x * NWAVES;
    const int gt = gw * 64 + lane, NGT = NGW * 64;
    constexpr int I_IN = (1024 / 64) * (INW / 32), I_OA = (512 / 64) * (1024 / 32), I_OS = I_OA, I_GL = (512 / 64) * (512 / 32), I_OUT = (1024 / 64) * (1024 / 32), I_PG = I_OUT, I_PP = (256 / 64) * (1024 / 32);
    constexpr int NITEMS = I_IN + I_OA + I_OS + I_GL + I_OUT + I_PG + I_PP;
    for (int it = gw; it < NITEMS; it += NGW) {
        int r = it;
        if (r < I_IN)  { p0_transpose_item(a->w_in, 1024, INW, (bf16*)(ws + WS_WIN), 0, scr, r, lane); continue; } r -= I_IN;
        if (r < I_OA)  { p0_transpose_item(a->w_o_attn, 512, 1024, (bf16*)(ws + WS_WST), 0, scr, r, lane); continue; } r -= I_OA;
        if (r < I_OS)  { p0_transpose_item(a->w_o_ssm, 512, 1024, (bf16*)(ws + WS_WST), 1024, scr, r, lane); continue; } r -= I_OS;
        if (r < I_GL)  { p0_transpose_item(a->w_glu, 512, 512, (bf16*)(ws + WS_WGLU), 0, scr, r, lane); continue; } r -= I_GL;
        if (r < I_OUT) { p0_transpose_item(a->w_out, 1024, 1024, (bf16*)(ws + WS_WOUT), 0, scr, r, lane); continue; } r -= I_OUT;
        if (r < I_PG)  { p0_transpose_item(a->w_pg, 1024, 1024, (bf16*)(ws + WS_WPG), 0, scr, r, lane); continue; } r -= I_PG;
        p0_transpose_item(a->w_pp, 256, 1024, (bf16*)(ws + WS_WPP), 0, scr, r, lane);
    }
    for (int m0 = gw; m0 < M; m0 += 2 * NGW) {
        const int m1 = m0 + NGW;
        const float* xr0 = m0 < MP ? a->x_prompt + (size_t)m0 * DM : a->x_sample + (size_t)(m0 - MP) * DM;
        const float* pr0 = m0 < MP ? a->p_prompt + (size_t)m0 * PLE : a->p_sample + (size_t)(m0 - MP) * PLE;
        const bool two = m1 < M;
        const int m1c = two ? m1 : m0;
        const float* xr1 = m1c < MP ? a->x_prompt + (size_t)m1c * DM : a->x_sample + (size_t)(m1c - MP) * DM;
        const float* pr1 = m1c < MP ? a->p_prompt + (size_t)m1c * PLE : a->p_sample + (size_t)(m1c - MP) * PLE;
        f32x4 v0[4], v1[4];
#pragma unroll
        for (int j = 0; j < 4; ++j) { v0[j] = ((const GAS f32x4*)xr0)[lane + 64 * j]; v1[j] = ((const GAS f32x4*)xr1)[lane + 64 * j]; }
        const f32x4 pv0 = ((const GAS f32x4*)pr0)[lane], pv1 = ((const GAS f32x4*)pr1)[lane];
        float s0 = 0.f, s1 = 0.f;
#pragma unroll
        for (int j = 0; j < 4; ++j) { s0 += (v0[j].x * v0[j].x + v0[j].y * v0[j].y) + (v0[j].z * v0[j].z + v0[j].w * v0[j].w); s1 += (v1[j].x * v1[j].x + v1[j].y * v1[j].y) + (v1[j].z * v1[j].z + v1[j].w * v1[j].w); }
        const float r0 = 1.f / sqrtf(wave_sum(s0) * (1.f / DM) + EPS), r1 = 1.f / sqrtf(wave_sum(s1) * (1.f / DM) + EPS);
        GAS v2u* o0 = (GAS v2u*)((bf16*)(ws + WS_XN) + (size_t)m0 * DM) + lane; GAS v2u* o1 = (GAS v2u*)((bf16*)(ws + WS_XN) + (size_t)m1c * DM) + lane;
#pragma unroll
        for (int j = 0; j < 4; ++j) {
            const f32x4 g = ((const GAS f32x4*)a->norm_gain)[lane + 64 * j];
            v2u o; o.x = pk2(v0[j].x * r0 * g.x, v0[j].y * r0 * g.y); o.y = pk2(v0[j].z * r0 * g.z, v0[j].w * r0 * g.w); o0[64 * j] = o;
            if (two) { v2u q; q.x = pk2(v1[j].x * r1 * g.x, v1[j].y * r1 * g.y); q.y = pk2(v1[j].z * r1 * g.z, v1[j].w * r1 * g.w); o1[64 * j] = q; }
        }
        { v2u o; o.x = pk2(pv0.x, pv0.y); o.y = pk2(pv0.z, pv0.w); ((GAS v2u*)((bf16*)(ws + WS_P) + (size_t)m0 * PLE))[lane] = o; }
        if (two) { v2u o; o.x = pk2(pv1.x, pv1.y); o.y = pk2(pv1.z, pv1.w); ((GAS v2u*)((bf16*)(ws + WS_P) + (size_t)m1c * PLE))[lane] = o; }
    }
    for (int i = gt; i < 2 * 16384; i += NGT) {
        const int which = i >> 14, j = i & 16383, b = j >> 11, r = j & 2047;
        const float* src = (which ? a->cache_v : a->cache_k) + (size_t)b * 16384 + 8192;
        float* dst = a->out + (which ? OFF_VS : OFF_KS) + (size_t)b * 16384;
        ((GAS f32x4*)dst)[r] = ((const GAS f32x4*)src)[r];
    }
    for (int i = gt; i < 2048 * 8; i += NGT) {
        const int pos = i >> 3, f = i & 7;
        const double INV[8] = {1.0, 0.19392274474868576, 0.03760603093086393, 0.007292664737217109, 0.001414213562373095, 0.0002742481756762073, 5.318295896944988e-05, 1.031338537721246e-05};
        double inv = INV[0];
#pragma unroll
        for (int q = 1; q < 8; ++q) inv = (f == q) ? INV[q] : inv;
        const float ang = (float)pos * (float)inv;
        double s, c; sincos_d((double)ang, s, c);
        float* rt = (float*)(ws + WS_ROPE) + (size_t)i * 2; rt[0] = (float)c; rt[1] = (float)s;
    }
    for (int it = gt; it < 32 * 64; it += NGT) {
        const int g = it >> 6, p = it & 63;
        const double lr = (double)a->a_re[it], li = (double)a->a_im[it], dt = exp_d((double)a->log_dt[g]);
        const double xr = lr * dt, th = li * dt;
        double sn, cs, sh, ch; sincos_d(th, sn, cs); sincos_d(0.5 * th, sh, ch);
        const double em1 = expm1_small_d(xr), ex = em1 + 1.0;
        const double ar = ex * cs, ai = ex * sn;
        const double ur = em1 * cs - 2.0 * sh * sh, ui = ai;
        const double den = lr * lr + li * li;
        const double cr = (ur * lr + ui * li) / den, ci = (ui * lr - ur * li) / den;
        bf16* Bb = (bf16*)(ws + WS_SSMB);
#pragma unroll
        for (int c = 0; c < 16; ++c) {
            const double br = (double)a->b_re[(size_t)it * 16 + c], bi = (double)a->b_im[(size_t)it * 16 + c];
            Bb[(size_t)(g * 128 + p) * 16 + c] = f2bf((float)(cr * br - ci * bi));
            Bb[(size_t)(g * 128 + 64 + p) * 16 + c] = f2bf((float)(cr * bi + ci * br));
        }
        bf16* Cm = (bf16*)(ws + WS_SSMC);
        const int kq = 4 * (p & 31) + 2 * (p >> 5);
#pragma unroll
        for (int co = 0; co < 16; ++co) {
            Cm[(size_t)(g * 16 + co) * 128 + kq] = f2bf(a->c_re[(size_t)(g * 16 + co) * 64 + p]);
            Cm[(size_t)(g * 16 + co) * 128 + kq + 1] = f2bf(-a->c_im[(size_t)(g * 16 + co) * 64 + p]);
        }
        float* ap = (float*)(ws + WS_APOW) + (size_t)it * 12;
        const double a2r = ar * ar - ai * ai, a2i = 2.0 * ar * ai;
        const double a3r = a2r * ar - a2i * ai, a3i = a2r * ai + a2i * ar;
        const double a4r = a2r * a2r - a2i * a2i, a4i = 2.0 * a2r * a2i;
        const double a8r = a4r * a4r - a4i * a4i, a8i = 2.0 * a4r * a4i;
        double pr = a8r, pi = a8i;
#pragma unroll
        for (int q = 0; q < 3; ++q) { const double t = pr * pr - pi * pi; pi = 2.0 * pr * pi; pr = t; }
        ap[0] = (float)ar; ap[1] = (float)ai; ap[2] = (float)a2r; ap[3] = (float)a2i; ap[4] = (float)a3r; ap[5] = (float)a3i;
        ap[6] = (float)a4r; ap[7] = (float)a4i; ap[8] = (float)a8r; ap[9] = (float)a8i; ap[10] = (float)pr; ap[11] = (float)pi;
    }
}

#define MFMA32(a, b, c) __builtin_amdgcn_mfma_f32_32x32x16_bf16((a), (b), (c), 0, 0, 0)
#define MFMA16(a, b, c) __builtin_amdgcn_mfma_f32_16x16x32_bf16((a), (b), (c), 0, 0, 0)
__device__ __forceinline__ bf16x8 pack_regs8(const f32x16& x, const int s) {
    v4u p; p.x = cvtpk_s(x[8 * s + 0], x[8 * s + 1]); p.y = cvtpk_s(x[8 * s + 2], x[8 * s + 3]); p.z = cvtpk_s(x[8 * s + 4], x[8 * s + 5]); p.w = cvtpk_s(x[8 * s + 6], x[8 * s + 7]);
    return __builtin_bit_cast(bf16x8, p);
}
__device__ __forceinline__ void attn_unit(AP a, LAS unsigned char* lds, int unit, int tid, int wave, int lane) {
    asm volatile("" : "+v"(tid), "+v"(lane));
    unsigned char* ws = a->ws;
    const bf16* Qb = (const bf16*)(ws + WS_Q); const bf16* Kb = (const bf16*)(ws + WS_K); const bf16* Vb = (const bf16*)(ws + WS_V);
    const bf16* ZA = (const bf16*)(ws + WS_ZA); bf16* A1 = (bf16*)(ws + WS_AST);
    const int kvh = unit & 1;
    const bool smp = unit >= 512;
    const int cr = smp ? 256 + ((unit - 512) >> 1) : (unit >> 1);
    const int row0 = cr * 64, c = cr & 31;
    const int kb_lo = smp ? 0 : (c >= 2 ? 0 : (2 - c) * 2);
#pragma unroll
    for (int i = 0; i < 3; ++i) {
        const int q = tid + 512 * i, key = q >> 3, ch = q & 7;
        v4u kv = {0u, 0u, 0u, 0u}, vv = {0u, 0u, 0u, 0u};
        if (smp) {
            if (key < 128) {
                const size_t o = ((size_t)((cr - 256) * 128 + key) * 2 + kvh) * 64 + ch * 8;
                const f32x4 k0 = *(const GAS f32x4*)(a->cache_k + o), k1 = *(const GAS f32x4*)(a->cache_k + o + 4);
                const f32x4 v0 = *(const GAS f32x4*)(a->cache_v + o), v1 = *(const GAS f32x4*)(a->cache_v + o + 4);
                kv.x = pk2(k0.x, k0.y); kv.y = pk2(k0.z, k0.w); kv.z = pk2(k1.x, k1.y); kv.w = pk2(k1.z, k1.w);
                vv.x = pk2(v0.x, v0.y); vv.y = pk2(v0.z, v0.w); vv.z = pk2(v1.x, v1.y); vv.w = pk2(v1.z, v1.w);
            } else {
                const size_t o = (size_t)(row0 + key - 128) * 128 + kvh * 64 + ch * 8;
                kv = *(const GAS v4u*)(Kb + o); vv = *(const GAS v4u*)(Vb + o);
            }
        } else {
            const int kc = key >> 6;
            if (c - 2 + kc >= 0) {
                const size_t o = (size_t)(row0 + (kc - 2) * 64 + (key & 63)) * 128 + kvh * 64 + ch * 8;
                kv = *(const GAS v4u*)(Kb + o); vv = *(const GAS v4u*)(Vb + o);
            }
        }
        *(LAS v4u*)(lds + LDS_KL + key * KL_STRIDE + ch * 16) = kv;
        const int w = key & 15, pos = (key & ~15) | (w & 3) | ((w & 4) << 1) | ((w & 8) >> 1);
        LAS bf16* vt = (LAS bf16*)(lds + LDS_VT) + pos;
        const int d0 = ch * 8;
        vt[(d0 + 0) * (VT_STRIDE / 2)] = (bf16)(vv.x & 0xffffu); vt[(d0 + 1) * (VT_STRIDE / 2)] = (bf16)(vv.x >> 16);
        vt[(d0 + 2) * (VT_STRIDE / 2)] = (bf16)(vv.y & 0xffffu); vt[(d0 + 3) * (VT_STRIDE / 2)] = (bf16)(vv.y >> 16);
        vt[(d0 + 4) * (VT_STRIDE / 2)] = (bf16)(vv.z & 0xffffu); vt[(d0 + 5) * (VT_STRIDE / 2)] = (bf16)(vv.z >> 16);
        vt[(d0 + 6) * (VT_STRIDE / 2)] = (bf16)(vv.w & 0xffffu); vt[(d0 + 7) * (VT_STRIDE / 2)] = (bf16)(vv.w >> 16);
    }
    __syncthreads();
    const int hq = kvh * 4 + (wave >> 1), th = wave & 1, r32 = lane & 31, h = lane >> 5;
    const int qrow = row0 + th * 32 + r32;
    bf16x8 qf[4];
#pragma unroll
    for (int s = 0; s < 4; ++s) qf[s] = *(const GAS bf16x8*)(Qb + (size_t)qrow * 512 + hq * 64 + 16 * s + 8 * h);
    f32x16 st[6];
    const float SC = 0.125f * 1.4426950408889634f;
    const float sink2 = a->sinks[hq] * 1.4426950408889634f;
    float mx = sink2;
#pragma unroll
    for (int kb = 0; kb < 6; ++kb) {
#pragma unroll
        for (int r = 0; r < 16; ++r) st[kb][r] = 0.f;
        if (kb >= kb_lo) {
#pragma unroll
            for (int s = 0; s < 4; ++s) {
                const bf16x8 kf = *(const LAS bf16x8*)(lds + LDS_KL + (kb * 32 + r32) * KL_STRIDE + (16 * s + 8 * h) * 2);
                st[kb] = MFMA32(kf, qf[s], st[kb]);
            }
#pragma unroll
            for (int r = 0; r < 16; ++r) { st[kb][r] *= SC; mx = fmaxf(mx, st[kb][r]); }
        }
    }
    mx = fmaxf(mx, __shfl_xor(mx, 32));
    float sum = 0.f;
#pragma unroll
    for (int kb = 0; kb < 6; ++kb) {
        if (kb >= kb_lo) {
#pragma unroll
            for (int r = 0; r < 16; ++r) { const float e = __builtin_amdgcn_exp2f(st[kb][r] - mx); st[kb][r] = e; sum += e; }
        }
    }
    sum += __shfl_xor(sum, 32);
    const float inv = 1.0f / (sum + __builtin_amdgcn_exp2f(sink2 - mx));
    f32x16 o[2];
#pragma unroll
    for (int db = 0; db < 2; ++db)
#pragma unroll
        for (int r = 0; r < 16; ++r) o[db][r] = 0.f;
#pragma unroll
    for (int kb = 0; kb < 6; ++kb) {
        if (kb >= kb_lo) {
#pragma unroll
            for (int s = 0; s < 2; ++s) {
                const bf16x8 pf = pack_regs8(st[kb], s);
#pragma unroll
                for (int db = 0; db < 2; ++db) {
                    const bf16x8 vf = *(const LAS bf16x8*)(lds + LDS_VT + (db * 32 + r32) * VT_STRIDE + (kb * 32 + 16 * s + 8 * h) * 2);
                    o[db] = MFMA32(vf, pf, o[db]);
                }
            }
        }
    }
#pragma unroll
    for (int db = 0; db < 2; ++db)
#pragma unroll
        for (int g4 = 0; g4 < 4; ++g4) {
            const size_t off = (size_t)qrow * 512 + hq * 64 + db * 32 + 8 * g4 + 4 * h;
            const v2u z = *(const GAS v2u*)(ZA + off);
            v2u w; w.x = pk2(o[db][4 * g4 + 0] * inv * bf_lo(z.x), o[db][4 * g4 + 1] * inv * bf_hi(z.x)); w.y = pk2(o[db][4 * g4 + 2] * inv * bf_lo(z.y), o[db][4 * g4 + 3] * inv * bf_hi(z.y));
            *(GAS v2u*)(A1 + off) = w;
        }
    __syncthreads();
}

struct SsmPre { bf16x8 bb[4]; f32x4 ap[2][3]; bf16x8 uf[2]; };
__device__ __forceinline__ void ssm_pre_load(SsmPre& P, AP a, int cr, int g, int lane) {
    unsigned char* ws = a->ws;
    const bf16* U = (const bf16*)(ws + WS_U); const bf16* Bb = (const bf16*)(ws + WS_SSMB); const float* apow = (const float*)(ws + WS_APOW);
    const int p32 = lane & 31, h = lane >> 5, row0 = cr * 64;
#pragma unroll
    for (int nb = 0; nb < 4; ++nb) P.bb[nb] = *(const GAS bf16x8*)(Bb + (size_t)(g * 128 + nb * 32 + p32) * 16 + 8 * h);
#pragma unroll
    for (int pi = 0; pi < 2; ++pi) {
        const GAS f32x4* ap = (const GAS f32x4*)(apow + (size_t)(g * 64 + pi * 32 + p32) * 12);
        P.ap[pi][0] = ap[0]; P.ap[pi][1] = ap[1]; P.ap[pi][2] = ap[2];
    }
#pragma unroll
    for (int tb = 0; tb < 2; ++tb) P.uf[tb] = *(const GAS bf16x8*)(U + (size_t)(row0 + tb * 32 + p32) * 512 + g * 16 + 8 * h);
    __builtin_amdgcn_sched_barrier(0);
}
__device__ __forceinline__ float lane_swap32(float x) {
    const unsigned u = __float_as_uint(x);
    const auto r = __builtin_amdgcn_permlane32_swap(u, u, false, false);
    return __uint_as_float((__builtin_amdgcn_mbcnt_hi(~0u, __builtin_amdgcn_mbcnt_lo(~0u, 0u)) & 32u) ? r[0] : r[1]);
}
template <bool FULL>
__device__ __forceinline__ void ssm_group(const SsmPre& P, AP a, LAS unsigned char* lds, int cr, int g, int wave, int lane, const float (&cy0r)[2], const float (&cy0i)[2]) {
    unsigned char* ws = a->ws;
    const bf16* U = (const bf16*)(ws + WS_U); const bf16* Cm = (const bf16*)(ws + WS_SSMC);
    const int p32 = lane & 31, h = lane >> 5, row0 = cr * 64;
    LAS unsigned char* Hl = lds + LDS_HL + wave * HL_WAVE;
    float A1r[2], A1i[2], A2r[2], A2i[2], A3r[2], A3i[2], A4r[2], A4i[2], A8r[2], A8i[2], cyr[2], cyi[2];
#pragma unroll
    for (int pi = 0; pi < 2; ++pi) {
        const f32x4 q0 = P.ap[pi][0], q1 = P.ap[pi][1], q2 = P.ap[pi][2];
        A1r[pi] = q0[0]; A1i[pi] = q0[1]; A2r[pi] = q0[2]; A2i[pi] = q0[3]; A3r[pi] = q1[0]; A3i[pi] = q1[1]; A4r[pi] = q1[2]; A4i[pi] = q1[3]; A8r[pi] = q2[0]; A8i[pi] = q2[1];
        cyr[pi] = cy0r[pi]; cyi[pi] = cy0i[pi];
    }
    const bf16x8* bb = P.bb; const bf16x8* ufs = P.uf;
    bf16x8 cmf[4];
    v2u uus[2][2]; f32x4 dsk = {0.f, 0.f, 0.f, 0.f};
    const int t16 = lane & 15, q4 = lane >> 4, ch = g * 16 + 4 * q4;
    if (FULL) {
#pragma unroll
        for (int ks = 0; ks < 4; ++ks) cmf[ks] = *(const GAS bf16x8*)(Cm + (size_t)(g * 16 + t16) * 128 + 32 * ks + 8 * q4);
        dsk = *(const GAS f32x4*)(a->ssm_d + ch);
#pragma unroll
        for (int tb = 0; tb < 2; ++tb)
#pragma unroll
            for (int mt = 0; mt < 2; ++mt) uus[tb][mt] = *(const GAS v2u*)(U + (size_t)(row0 + tb * 32 + 16 * mt + t16) * 512 + ch);
    }
    __builtin_amdgcn_sched_barrier(0);
#pragma unroll
    for (int tb = 0; tb < 2; ++tb) {
        const bf16x8 uf = ufs[tb];
        f32x16 x[4];
#pragma unroll
        for (int nb = 0; nb < 4; ++nb) {
#pragma unroll
            for (int r = 0; r < 16; ++r) x[nb][r] = 0.f;
            x[nb] = MFMA32(uf, bb[nb], x[nb]);
        }
#pragma unroll
        for (int pi = 0; pi < 2; ++pi) {
            f32x16& xr = x[pi]; f32x16& xi = x[2 + pi];
            const float a1r = A1r[pi], a1i = A1i[pi], a4r = A4r[pi], a4i = A4i[pi], a8r = A8r[pi], a8i = A8i[pi];
#pragma unroll
            for (int j = 0; j < 4; ++j) {
#pragma unroll
                for (int i = 1; i < 4; ++i) {
                    const float pr = xr[4 * j + i - 1], pim = xi[4 * j + i - 1];
                    xr[4 * j + i] += a1r * pr - a1i * pim;
                    xi[4 * j + i] += a1r * pim + a1i * pr;
                }
            }
            float Cr = cyr[pi], Ci = cyi[pi];
            float car[4], cai[4];
#pragma unroll
            for (int j = 0; j < 4; ++j) {
                const float er = xr[4 * j + 3], ei = xi[4 * j + 3];
                const float per = lane_swap32(er), pei = lane_swap32(ei);
                const float evr = h == 0 ? er : per, evi = h == 0 ? ei : pei;
                const float odr = h == 0 ? per : er, odi = h == 0 ? pei : ei;
                const float t4r = a4r * Cr - a4i * Ci + evr, t4i = a4r * Ci + a4i * Cr + evi;
                car[j] = h == 0 ? Cr : t4r; cai[j] = h == 0 ? Ci : t4i;
                const float Er = a4r * evr - a4i * evi + odr, Ei = a4r * evi + a4i * evr + odi;
                const float nr = a8r * Cr - a8i * Ci + Er, ni = a8r * Ci + a8i * Cr + Ei;
                Cr = nr; Ci = ni;
            }
            cyr[pi] = Cr; cyi[pi] = Ci;
            if (FULL) {
                const float pw_r[4] = {a1r, A2r[pi], A3r[pi], a4r}, pw_i[4] = {a1i, A2i[pi], A3i[pi], a4i};
#pragma unroll
                for (int j = 0; j < 4; ++j)
#pragma unroll
                    for (int i = 0; i < 4; ++i) {
                        const float hr = xr[4 * j + i] + pw_r[i] * car[j] - pw_i[i] * cai[j];
                        const float hi = xi[4 * j + i] + pw_r[i] * cai[j] + pw_i[i] * car[j];
                        const int trow = i + 8 * j + 4 * h;
                        *(LAS unsigned*)(Hl + trow * HL_STRIDE + p32 * 8 + pi * 4) = cvtpk_s(hr, hi);
                    }
            }
        }
        if (FULL) {
            bf16* Zg = (bf16*)(ws + WS_Z);
#pragma unroll
            for (int mt = 0; mt < 2; ++mt) {
                f32x4 ya = {0.f, 0.f, 0.f, 0.f};
#pragma unroll
                for (int ks = 0; ks < 4; ++ks) {
                    const bf16x8 hb = *(const LAS bf16x8*)(Hl + (16 * mt + t16) * HL_STRIDE + (32 * ks + 8 * q4) * 2);
                    ya = MFMA16(cmf[ks], hb, ya);
                }
                const int t = tb * 32 + 16 * mt + t16;
                const v2u uu = uus[tb][mt];
                const float z0 = gelu_tanh_f(ya[0] + dsk[0] * bf_lo(uu.x)), z1 = gelu_tanh_f(ya[1] + dsk[1] * bf_hi(uu.x));
                const float z2 = gelu_tanh_f(ya[2] + dsk[2] * bf_lo(uu.y)), z3 = gelu_tanh_f(ya[3] + dsk[3] * bf_hi(uu.y));
                v2u w; w.x = pk2(z0, z1); w.y = pk2(z2, z3);
                *(GAS v2u*)(Zg + (size_t)(row0 + t) * 512 + ch) = w;
            }
        }
    }
    if (!FULL) {
        if (h == 0) {
            float* S = (float*)(ws + WS_SLOC) + (size_t)(cr * 32 + g) * 128;
#pragma unroll
            for (int pi = 0; pi < 2; ++pi) { S[pi * 32 + p32] = cyr[pi]; S[64 + pi * 32 + p32] = cyi[pi]; }
        }
    } else {
        const bool smp = cr >= 256;
        if ((smp || (cr & 31) == 31) && h == 0) {
            const int b = smp ? cr - 256 : cr >> 5;
            float* sr = a->out + (smp ? OFF_SRS : OFF_SRP) + (size_t)(b * 32 + g) * 64;
            float* si = a->out + (smp ? OFF_SIS : OFF_SIP) + (size_t)(b * 32 + g) * 64;
#pragma unroll
            for (int pi = 0; pi < 2; ++pi) { sr[pi * 32 + p32] = cyr[pi]; si[pi * 32 + p32] = cyi[pi]; }
        }
    }
}

__device__ __forceinline__ void ssm_local_items(AP a, LAS unsigned char* lds, int wave, int lane) {
    asm volatile("" : "+v"(lane));
    const int gw = blockIdx.x * NWAVES + wave, NGW = gridDim.x * NWAVES;
    const float z2[2] = {0.f, 0.f};
    for (int i = gw; i < 256 * 32; i += NGW) {
        SsmPre p0;
        ssm_pre_load(p0, a, i >> 5, i & 31, lane);
        ssm_group<false>(p0, a, lds, i >> 5, i & 31, wave, lane, z2, z2);
    }
}
__device__ __forceinline__ void ssm_carry_in(AP a, int cr, int g, int lane, float (&hr)[2], float (&hi)[2]) {
    unsigned char* ws = a->ws;
    const float* apow = (const float*)(ws + WS_APOW); const float* Sl = (const float*)(ws + WS_SLOC);
    const int p32 = lane & 31, c = cr & 31;
    hr[0] = hr[1] = hi[0] = hi[1] = 0.f;
    if (cr >= 256) {
#pragma unroll
        for (int pi = 0; pi < 2; ++pi) { const size_t o = (size_t)((cr - 256) * 32 + g) * 64 + pi * 32 + p32; hr[pi] = a->st_re[o]; hi[pi] = a->st_im[o]; }
    } else if (c > 0) {
        float ar[2], ai[2];
#pragma unroll
        for (int pi = 0; pi < 2; ++pi) { const float* ap = apow + (size_t)(g * 64 + pi * 32 + p32) * 12; ar[pi] = ap[10]; ai[pi] = ap[11]; }
        const float* S0 = Sl + (size_t)((cr - c) * 32 + g) * 128 + p32;
        for (int j0 = 0; j0 < c; j0 += 8) {
            float sr[8][2], si[8][2];
#pragma unroll
            for (int jj = 0; jj < 8; ++jj) {
                const int j = (j0 + jj < c) ? j0 + jj : c - 1;
#pragma unroll
                for (int pi = 0; pi < 2; ++pi) { sr[jj][pi] = S0[(size_t)j * 4096 + pi * 32]; si[jj][pi] = S0[(size_t)j * 4096 + 64 + pi * 32]; }
            }
#pragma unroll
            for (int jj = 0; jj < 8; ++jj) {
                if (j0 + jj < c) {
#pragma unroll
                    for (int pi = 0; pi < 2; ++pi) { const float nr = ar[pi] * hr[pi] - ai[pi] * hi[pi] + sr[jj][pi], ni = ar[pi] * hi[pi] + ai[pi] * hr[pi] + si[jj][pi]; hr[pi] = nr; hi[pi] = ni; }
                }
            }
        }
    }
}
__device__ __forceinline__ void ssm_full_items(AP a, LAS unsigned char* lds, int wave, int lane) {
    asm volatile("" : "+v"(lane));
    const int gw = blockIdx.x * NWAVES + wave, NGW = gridDim.x * NWAVES;
    for (int i = gw; i < 264 * 32; i += NGW) {
        SsmPre p0; float hr[2], hi[2];
        ssm_pre_load(p0, a, i >> 5, i & 31, lane);
        ssm_carry_in(a, i >> 5, i & 31, lane, hr, hi);
        ssm_group<true>(p0, a, lds, i >> 5, i & 31, wave, lane, hr, hi);
    }
}

constexpr int MPT_STRIDE = 272, MPT_WAVE = 32 * MPT_STRIDE;
template <int KS>
__device__ __forceinline__ void mini_acc(f32x4 (&acc)[2][4], const bf16* A, int lda, const bf16* Bt, int ldb, int kbeg, int lane) {
    const int l16 = lane & 15, q4 = lane >> 4;
    bf16x8 af[KS][2], bfr[KS][4];
#pragma unroll
    for (int ks = 0; ks < KS; ++ks) {
        const int k = kbeg + 32 * ks + 8 * q4;
#pragma unroll
        for (int mt = 0; mt < 2; ++mt) af[ks][mt] = *(const GAS bf16x8*)(A + (size_t)(16 * mt + l16) * lda + k);
#pragma unroll
        for (int nt = 0; nt < 4; ++nt) bfr[ks][nt] = *(const GAS bf16x8*)(Bt + (size_t)(16 * nt + l16) * ldb + k);
    }
#pragma unroll
    for (int ks = 0; ks < KS; ++ks)
#pragma unroll
        for (int mt = 0; mt < 2; ++mt)
#pragma unroll
            for (int nt = 0; nt < 4; ++nt) acc[mt][nt] = MFMA16(bfr[ks][nt], af[ks][mt], acc[mt][nt]);
}
__device__ __forceinline__ f32x4 mini_reduce(LAS unsigned char* lds, const f32x4 (&acc)[2][4], int tid, int wave, int lane) {
    const int l16 = lane & 15, q4 = lane >> 4;
#pragma unroll
    for (int mt = 0; mt < 2; ++mt)
#pragma unroll
        for (int nt = 0; nt < 4; ++nt) *(LAS f32x4*)(lds + wave * MPT_WAVE + (16 * mt + l16) * MPT_STRIDE + (16 * nt + 4 * q4) * 4) = acc[mt][nt];
    __syncthreads();
    const int t = tid >> 4, n4 = (tid & 15) * 4;
    f32x4 s = {0.f, 0.f, 0.f, 0.f};
#pragma unroll
    for (int w = 0; w < NWAVES; ++w) s += *(const LAS f32x4*)(lds + w * MPT_WAVE + t * MPT_STRIDE + n4 * 4);
    __syncthreads();
    return s;
}
#define MINI_ZERO(acc) _Pragma("unroll") for (int _m = 0; _m < 2; ++_m) _Pragma("unroll") for (int _n = 0; _n < 4; ++_n) acc[_m][_n] = (f32x4){0.f, 0.f, 0.f, 0.f}
__device__ __forceinline__ void mini_merge(AP a, LAS unsigned char* lds, int item, int tid, int wave, int lane) {
    asm volatile("" : "+v"(tid), "+v"(lane));
    unsigned char* ws = a->ws;
    const int rb = item >> 4, cb = item & 15, r0 = MP + 32 * rb, n0 = 64 * cb;
    const bf16* AST = (const bf16*)(ws + WS_AST); const bf16* WST = (const bf16*)(ws + WS_WST);
    f32x4 ya[2][4], ys[2][4]; MINI_ZERO(ya); MINI_ZERO(ys);
    mini_acc<2>(ya, AST + (size_t)r0 * 512, 512, WST + (size_t)n0 * 512, 512, wave * 64, lane);
    mini_acc<2>(ys, AST + (size_t)(M + r0) * 512, 512, WST + (size_t)(1024 + n0) * 512, 512, wave * 64, lane);
    const bf16* GA = (const bf16*)(ws + WS_GA); const bf16* GS = (const bf16*)(ws + WS_GS);
    const int l16 = lane & 15, q4 = lane >> 4;
#pragma unroll
    for (int mt = 0; mt < 2; ++mt)
#pragma unroll
        for (int nt = 0; nt < 4; ++nt) {
            const size_t o = (size_t)(r0 + 16 * mt + l16) * DM + n0 + 16 * nt + 4 * q4;
            const v2u ga = *(const GAS v2u*)(GA + o), gs = *(const GAS v2u*)(GS + o);
            ya[mt][nt][0] = ya[mt][nt][0] * bf_lo(ga.x) + ys[mt][nt][0] * bf_lo(gs.x); ya[mt][nt][1] = ya[mt][nt][1] * bf_hi(ga.x) + ys[mt][nt][1] * bf_hi(gs.x);
            ya[mt][nt][2] = ya[mt][nt][2] * bf_lo(ga.y) + ys[mt][nt][2] * bf_lo(gs.y); ya[mt][nt][3] = ya[mt][nt][3] * bf_hi(ga.y) + ys[mt][nt][3] * bf_hi(gs.y);
        }
    const f32x4 v = mini_reduce(lds, ya, tid, wave, lane);
    const int t = tid >> 4, n4 = (tid & 15) * 4;
    v2u w; w.x = pk2(v[0], v[1]); w.y = pk2(v[2], v[3]);
    *(GAS v2u*)((bf16*)(ws + WS_XN) + (size_t)(r0 + t) * DM + n0 + n4) = w;
}
__device__ __forceinline__ void mini_h1_pp(AP a, LAS unsigned char* lds, int item, int tid, int wave, int lane) {
    asm volatile("" : "+v"(tid), "+v"(lane));
    unsigned char* ws = a->ws;
    const int rb = item >> 4, cb = item & 15, r0 = MP + 32 * rb, n0 = 64 * cb;
    const int t = tid >> 4, n4 = (tid & 15) * 4;
    {
        f32x4 acc[2][4]; MINI_ZERO(acc);
        mini_acc<4>(acc, (const bf16*)(ws + WS_XN) + (size_t)r0 * DM, DM, (const bf16*)(ws + WS_WOUT) + (size_t)n0 * DM, DM, wave * 128, lane);
        const f32x4 v = mini_reduce(lds, acc, tid, wave, lane);
        const size_t o = (size_t)(r0 + t) * DM + n0 + n4;
        const f32x4 h = *(const GAS f32x4*)(a->x_sample + (o - (size_t)MP * DM)) + v;
        *(GAS f32x4*)(a->out + o) = h;
        v2u w; w.x = pk2(h[0], h[1]); w.y = pk2(h[2], h[3]);
        *(GAS v2u*)((bf16*)(ws + WS_GA) + o) = w;
    }
    {
        f32x4 acc[2][4]; MINI_ZERO(acc);
        mini_acc<1>(acc, (const bf16*)(ws + WS_P) + (size_t)r0 * PLE, PLE, (const bf16*)(ws + WS_WPP) + (size_t)n0 * PLE, PLE, wave * 32, lane);
        const f32x4 v = mini_reduce(lds, acc, tid, wave, lane);
        v2u w; w.x = pk2(v[0], v[1]); w.y = pk2(v[2], v[3]);
        *(GAS v2u*)((bf16*)(ws + WS_GS) + (size_t)(r0 + t) * DM + n0 + n4) = w;
    }
}
__device__ __forceinline__ void mini_h2(AP a, LAS unsigned char* lds, int item, int tid, int wave, int lane) {
    asm volatile("" : "+v"(tid), "+v"(lane));
    unsigned char* ws = a->ws;
    const int rb = item >> 4, cb = item & 15, r0 = MP + 32 * rb, n0 = 64 * cb;
    const int t = tid >> 4, n4 = (tid & 15) * 4;
    f32x4 acc[2][4]; MINI_ZERO(acc);
    mini_acc<4>(acc, (const bf16*)(ws + WS_GA) + (size_t)r0 * DM, DM, (const bf16*)(ws + WS_WPG) + (size_t)n0 * DM, DM, wave * 128, lane);
    const f32x4 v = mini_reduce(lds, acc, tid, wave, lane);
    const size_t o = (size_t)(r0 + t) * DM + n0 + n4;
    const v2u pp = *(const GAS v2u*)((const bf16*)(ws + WS_GS) + o);
    f32x4 h = *(const GAS f32x4*)(a->out + o);
    h[0] += sigmoid_f(v[0]) * bf_lo(pp.x); h[1] += sigmoid_f(v[1]) * bf_hi(pp.x); h[2] += sigmoid_f(v[2]) * bf_lo(pp.y); h[3] += sigmoid_f(v[3]) * bf_hi(pp.y);
    *(GAS f32x4*)(a->out + o) = h;
    float sq = (h[0] * h[0] + h[1] * h[1]) + (h[2] * h[2] + h[3] * h[3]);
    sq += __shfl_xor(sq, 1); sq += __shfl_xor(sq, 2); sq += __shfl_xor(sq, 4); sq += __shfl_xor(sq, 8);
    if ((tid & 15) == 0) ((float*)(ws + WS_SSQ))[(size_t)(r0 + t) * 16 + cb] = sq;
}

__device__ __forceinline__ void final_norm_row(AP a, int m, int lane) {
    GAS f32x4* yr = (GAS f32x4*)(a->out + (size_t)m * DM) + lane; const GAS f32x4* gr = (const GAS f32x4*)a->fgain + lane;
    const float* sq = (const float*)(a->ws + WS_SSQ) + (size_t)m * 16;
    const f32x4 s0 = *(const GAS f32x4*)sq, s1 = *(const GAS f32x4*)(sq + 4), s2 = *(const GAS f32x4*)(sq + 8), s3 = *(const GAS f32x4*)(sq + 12);
    const float ss = ((s0[0] + s0[1]) + (s0[2] + s0[3])) + ((s1[0] + s1[1]) + (s1[2] + s1[3])) + ((s2[0] + s2[1]) + (s2[2] + s2[3])) + ((s3[0] + s3[1]) + (s3[2] + s3[3]));
    const float r = 1.f / sqrtf(ss * (1.f / DM) + EPS);
#pragma unroll
    for (int j = 0; j < 4; ++j) { const f32x4 v = yr[64 * j], g = gr[64 * j]; yr[64 * j] = v * r * g; }
}

__global__ void __launch_bounds__(NWAVES * 64, 2) mega_fwd(Args args) {
    extern __shared__ __attribute__((aligned(16))) unsigned char lds_raw[];
    LAS unsigned char* lds = (LAS unsigned char*)lds_raw;
    volatile LAS unsigned* MISC = (volatile LAS unsigned*)(lds + MISC_OFF);
    const int tid = threadIdx.x, lane = tid & 63, wave = __builtin_amdgcn_readfirstlane(tid >> 6);
    const int G = gridDim.x, bx = blockIdx.x;
    gu32* ctl; { AP ap = args_ptr(); ctl = (gu32*)(ap->ws + WS_CTL); }
    for (int u = tid; u < (LDS_BYTES - MISC_OFF) / 4; u += NWAVES * 64) ((LAS unsigned*)(lds + MISC_OFF))[u] = 0u;
    __syncthreads();
    XcdBarrier bar; bar.bar = (unsigned*)(ctl + CW_BAR); bar.x = 0; bar.st = nullptr;
    if (N_LAUNCHES == 1) bar = xcd_barrier_post((unsigned*)(ctl + CW_BAR), MISC + 8);
#define GRID_BAR() do { if (N_LAUNCHES == 1) xcd_barrier(bar); } while (0)
    int lo, hi; { AP ap = args_ptr(); lo = ap->ph_lo; hi = ap->ph_hi; }
#define POS(k) ((k) <= 3 ? (k) : (k) == 8 ? 4 : (k) + 1)
#define IN(k) (lo <= POS(k) && POS(k) < hi)
#define BOTH(k) (IN(k) && lo <= POS(k) + 1 && POS(k) + 1 < hi)
#define REPS(k) 1

    if (IN(0)) { for (int rep = 0; rep < REPS(0); ++rep) { p0_prologue(args_ptr(), lds, wave, lane); if (BOTH(0) || rep + 1 < REPS(0)) GRID_BAR(); } }

    if (IN(1)) { for (int rep = 0; rep < REPS(1); ++rep) {
        AP ap = args_ptr(); unsigned char* ws = ap->ws;
        pg8::Gemm g{(const pg8::bf16_t*)(ws + WS_XN), (const pg8::bf16_t*)(ws + WS_WIN), M, INW, DM};
        pg8::StaticOrder S; S.init(M, INW, G, bx);
        pg8::EpiIn E{ws, ap->out};
        pg8::gemm_phase<pg8::EpiIn, pg8::StaticOrder, true, true>(lds, g, S, E);
        if (BOTH(1) || rep + 1 < REPS(1)) GRID_BAR();
    } }

    if (IN(2)) { for (int rep = 0; rep < REPS(2); ++rep) {
        AP ap = args_ptr();
        for (int u = bx; u < 528; u += G) attn_unit(ap, lds, u, tid, wave, lane);
        ssm_local_items(ap, lds, wave, lane);
        if (BOTH(2) || rep + 1 < REPS(2)) GRID_BAR();
    } }

    if (IN(3)) {
        AP ap = args_ptr();
        ssm_full_items(ap, lds, wave, lane);
        if (BOTH(3)) GRID_BAR();
    }

    if (IN(8)) {
        AP ap = args_ptr(); unsigned char* ws = ap->ws;
        pg8::Gemm g{(const pg8::bf16_t*)(ws + WS_Z), (const pg8::bf16_t*)(ws + WS_WGLU), M, 512, 512};
        pg8::StaticOrder S; S.init(M, 512, G, bx);
        pg8::EpiGLU E{ws};
        pg8::gemm_phase<pg8::EpiGLU, pg8::StaticOrder, true, true>(lds, g, S, E);
        if (BOTH(8)) GRID_BAR();
    }

    if (IN(4)) { for (int rep = 0; rep < REPS(4); ++rep) {
        AP ap = args_ptr(); unsigned char* ws = ap->ws;
        pg8::Gemm g{(const pg8::bf16_t*)(ws + WS_AST), (const pg8::bf16_t*)(ws + WS_WST), 2 * M, 2048, 512};
        pg8::PairOrder S; S.base.init(MP, DM, G, bx); S.dM = M / 256; S.dN = 4;
        pg8::EpiMerge E{ws};
        pg8::gemm_phase<pg8::EpiMerge, pg8::PairOrder, true, true>(lds, g, S, E);
        for (int it = bx; it < 256; it += G) mini_merge(ap, lds, it, tid, wave, lane);
        if (BOTH(4) || rep + 1 < REPS(4)) GRID_BAR();
    } }

    if (IN(5)) { for (int rep = 0; rep < REPS(5); ++rep) {
        AP ap = args_ptr(); unsigned char* ws = ap->ws;
        pg8::Gemm g{(const pg8::bf16_t*)(ws + WS_XN), (const pg8::bf16_t*)(ws + WS_WOUT), MP, DM, DM};
        pg8::StaticOrder S; S.init(MP, DM, G, bx);
        pg8::EpiH1 E{ap->x_prompt, ap->x_sample, ap->out, ws};
        pg8::gemm_phase<pg8::EpiH1, pg8::StaticOrder, true, true>(lds, g, S, E);
        for (int it = bx; it < 256; it += G) mini_h1_pp(ap, lds, it, tid, wave, lane);
        if (BOTH(5) || rep + 1 < REPS(5)) GRID_BAR();
    } }

    if (IN(6)) {
        AP ap = args_ptr(); unsigned char* ws = ap->ws;
        {
            pg8::Gemm g{(const pg8::bf16_t*)(ws + WS_P), (const pg8::bf16_t*)(ws + WS_WPP), MP, DM, PLE};
            pg8::StaticOrder S; S.init(MP, DM, G, bx);
            pg8::EpiPP E{ws};
            pg8::gemm_phase<pg8::EpiPP, pg8::StaticOrder, true, true>(lds, g, S, E);
        }
        {
            pg8::Gemm g{(const pg8::bf16_t*)(ws + WS_GA), (const pg8::bf16_t*)(ws + WS_WPG), MP, DM, DM};
            pg8::StaticOrder S; S.init(MP, DM, G, bx);
            pg8::EpiH2 E{ap->out, ws};
            pg8::gemm_phase<pg8::EpiH2, pg8::StaticOrder, true, true>(lds, g, S, E);
        }
        for (int it = bx; it < 256; it += G) mini_h2(ap, lds, it, tid, wave, lane);
        if (BOTH(6)) GRID_BAR();
    }

    if (IN(7)) {
        const int gw = bx * NWAVES + wave, NGW = G * NWAVES;
        AP ap = args_ptr();
        for (int m = gw; m < M; m += NGW) final_norm_row(ap, m, lane);
    }
#undef IN
#undef BOTH
}

#ifndef PROBE_EXTRA
#define PROBE_EXTRA -1
#endif
extern "C" void kernel_launch(void* const* d_in, const int* in_sizes, int n_in, void* d_out, int out_size, void* d_ws, size_t ws_size, hipStream_t stream) {
    static int grid = 0;
    if (grid == 0) {
        if (n_in != 26 || (size_t)out_size != OUT_TOTAL || ws_size < WS_END) { fprintf(stderr, "kernel_launch: unexpected shapes (n_in %d, out %d, ws %zu); nothing launched\n", n_in, out_size, ws_size); grid = -1; return; }
        int dev = 0, cus = 0, per_cu = 0;
        if (hipGetDevice(&dev) != hipSuccess || hipDeviceGetAttribute(&cus, hipDeviceAttributeMultiprocessorCount, dev) != hipSuccess) { grid = -1; return; }
        if (hipFuncSetAttribute((const void*)mega_fwd, hipFuncAttributeMaxDynamicSharedMemorySize, LDS_BYTES) != hipSuccess) { fprintf(stderr, "kernel_launch: hipFuncSetAttribute failed\n"); grid = -1; return; }
        if (hipOccupancyMaxActiveBlocksPerMultiprocessor(&per_cu, (const void*)mega_fwd, NWAVES * 64, LDS_BYTES) != hipSuccess || per_cu < 1) { fprintf(stderr, "kernel_launch: occupancy query says %d blocks per CU\n", per_cu); per_cu = 1; }
        (void)hipGetLastError();
        grid = cus;
    }
    if (grid < 0) return;
    if (hipMemsetAsync((char*)d_ws + WS_CTL, 0, CTL_ZERO_BYTES, stream) != hipSuccess) { fprintf(stderr, "kernel_launch: memset failed\n"); return; }
    Args a{};
    const float** pa = (const float**)&a;
    for (int i = 0; i < 26; ++i) pa[i] = (const float*)d_in[i];
    a.out = (float*)d_out; a.ws = (unsigned char*)d_ws;
    for (int li = 0; li < N_LAUNCHES; ++li) {
        a.ph_lo = (N_LAUNCHES == 1) ? 0 : li; a.ph_hi = (N_LAUNCHES == 1) ? N_PHASES : li + 1;
        for (int rep = 0; rep < ((N_LAUNCHES > 1 && li == PROBE_EXTRA) ? 2 : 1); ++rep) {
            hipLaunchKernelGGL(mega_fwd, dim3(grid), dim3(NWAVES * 64), LDS_BYTES, stream, a);
            const hipError_t le = hipPeekAtLastError();
            if (le != hipSuccess) { fprintf(stderr, "kernel_launch: launch %d failed: %s\n", li, hipGetErrorName(le)); break; }
        }
    }
}
```

```cpp
#include <hip/hip_runtime.h>
#include <cstdio>
#include <cstdint>

typedef float f32x2_t __attribute__((ext_vector_type(2)));
typedef __bf16 bf16x2_t __attribute__((ext_vector_type(2)));
__device__ __forceinline__ unsigned cvtpk_s(float lo, float hi) { f32x2_t v = {lo, hi}; bf16x2_t b = __builtin_convertvector(v, bf16x2_t); return __builtin_bit_cast(unsigned, b); }
__device__ __forceinline__ float bf_lo(unsigned w) { return __uint_as_float(w << 16); }
__device__ __forceinline__ float bf_hi(unsigned w) { return __uint_as_float(w & 0xffff0000u); }
__device__ __forceinline__ float fast_exp(float x) { return __builtin_amdgcn_exp2f(x * 1.4426950408889634f); }
__device__ __forceinline__ float sigmoid_f(float x) { return __builtin_amdgcn_rcpf(1.0f + fast_exp(-x)); }
__device__ __forceinline__ float silu_f(float x) { return x * sigmoid_f(x); }
__device__ __forceinline__ float gelu_tanh_f(float x) { const float u = 1.5957691216057308f * (x + 0.044715f * x * x * x); return x * sigmoid_f(u); }

constexpr int DM = 1024, SEQ = 2048, NB = 8, DSEQ = 64, MP = NB * SEQ  , MS = NB * DSEQ  , M = MP + MS  ;
constexpr int INW = 4352, PLE = 256, PAST = 1024;
constexpr float EPS = 1e-6f;
constexpr size_t OFF_Y = 0, OFF_KP = (size_t)M * DM, OFF_VP = OFF_KP + 131072, OFF_SRP = OFF_VP + 131072, OFF_SIP = OFF_SRP + 16384,
                 OFF_KS = OFF_SIP + 16384, OFF_VS = OFF_KS + 131072, OFF_SRS = OFF_VS + 131072, OFF_SIS = OFF_SRS + 16384, OUT_TOTAL = OFF_SIS + 16384;

constexpr size_t MiB = 1u << 20;
constexpr size_t WS_CTL = 0, CTL_ZERO_BYTES = 1 * MiB;
constexpr size_t WS_WIN = 2 * MiB;
constexpr size_t WS_WST = 11 * MiB;
constexpr size_t WS_WGLU = 13 * MiB;
constexpr size_t WS_WOUT = 14 * MiB;
constexpr size_t WS_WPG = 16 * MiB;
constexpr size_t WS_WPP = 18 * MiB;
constexpr size_t WS_ROPE = 19 * MiB;
constexpr size_t WS_SSMB = 19 * MiB + 256 * 1024;
constexpr size_t WS_SSMC = 19 * MiB + 512 * 1024;
constexpr size_t WS_APOW = 19 * MiB + 768 * 1024;
constexpr size_t WS_APOW256 = WS_APOW + 128 * 1024;
constexpr size_t WS_SLOC = 20 * MiB;
constexpr size_t WS_SSQ = 24 * MiB;
constexpr size_t WS_XN = 32 * MiB;
constexpr size_t WS_P = 66 * MiB;
constexpr size_t WS_Q = 75 * MiB;
constexpr size_t WS_Z = WS_XN;
constexpr size_t WS_K = 92 * MiB;
constexpr size_t WS_V = 97 * MiB;
constexpr size_t WS_ZA = 102 * MiB;
constexpr size_t WS_U = 119 * MiB;
constexpr size_t WS_ZS = 136 * MiB;
constexpr size_t WS_GA = 153 * MiB;
constexpr size_t WS_GS = 186 * MiB;
constexpr size_t WS_AST = 219 * MiB;
constexpr size_t WS_END = 252 * MiB;
static_assert(WS_XN + (size_t)M * 1024 * 2 <= WS_P && WS_P + (size_t)M * 256 * 2 <= WS_Q && WS_Q + (size_t)M * 512 * 2 <= WS_K && WS_K + (size_t)M * 128 * 2 <= WS_V && WS_V + (size_t)M * 128 * 2 <= WS_ZA &&
              WS_ZA + (size_t)M * 512 * 2 <= WS_U && WS_U + (size_t)M * 512 * 2 <= WS_ZS && WS_ZS + (size_t)M * 512 * 2 <= WS_GA && WS_GA + (size_t)M * 1024 * 2 <= WS_GS && WS_GS + (size_t)M * 1024 * 2 <= WS_AST &&
              WS_AST + (size_t)2 * M * 512 * 2 <= WS_END && WS_WIN + (size_t)INW * 1024 * 2 <= WS_WST && WS_SSQ + (size_t)M * 16 * 4 <= WS_XN, "d_ws map");
constexpr int CW_TMO = 0, CW_BAR = 4096;

namespace pg8 {
#define PG8_LAS __attribute__((address_space(3)))
typedef unsigned short bf16_t;
typedef short bf16x8 __attribute__((ext_vector_type(8)));
typedef float f32x4 __attribute__((ext_vector_type(4)));
typedef unsigned u32x4 __attribute__((ext_vector_type(4)));
constexpr int BM = 256, BK = 64, HALF = 128, HTB = HALF * BK * 2  , STAGE_BYTES = 8 * HTB, NXCD = 8, WGM = 8;

__host__ __device__ __forceinline__ int lds_byte(int r, int c) { const int st = (r >> 4) * 2 + (c >> 5), rr = r & 15, cc = c & 31, ob = rr * 64 + cc * 2; return st * 1024 + (ob ^ (((ob >> 9) & 1) << 5)); }
__host__ __device__ __forceinline__ void stage_rc(int b, int& R, int& C) { const int st = b / 1024, sb = b % 1024, swz = sb ^ (((sb >> 9) & 1) << 5); R = (st >> 1) * 16 + swz / 64; C = (st & 1) * 32 + (swz % 64) / 2; }
__host__ __device__ __forceinline__ int perm32(int rho) { const int n = rho >> 4, i = rho & 15; return 8 * (i >> 2) + 4 * n + (i & 3); }

struct Unit { int pm, pn; };
struct Gemm { const bf16_t* A; const bf16_t* Bt; int M, N, K; };

struct StaticOrder {
    int nM, nN, nwg, G, c;
    __host__ __device__ void init(int M, int N, int G_, int c_) { nM = M / BM; nN = N / BM; nwg = nM * nN; G = G_; c = c_; }
    __host__ __device__ bool next(int i, Unit& u) const {
        const long L = (long)i * G + c; if (L >= nwg) return false;
        int wgid = (int)L; { const int q = nwg / NXCD, r = nwg % NXCD, xcd = wgid % NXCD, off = wgid / NXCD; wgid = (xcd < r ? xcd * (q + 1) : r * (q + 1) + (xcd - r) * q) + off; }
        const int nig = WGM * nN, gid = wgid / nig, fm = gid * WGM, gsz = (nM - fm) < WGM ? (nM - fm) : WGM;
        u.pm = fm + ((wgid % nig) % gsz); u.pn = (wgid % nig) / gsz; return true;
    }
    __device__ __forceinline__ void a_ready(const Unit&) const {}
    __device__ __forceinline__ void done(const Unit&) const {}
};


struct PairOrder {
    StaticOrder base; int dM, dN;
    __host__ __device__ bool next(int i, Unit& u) const { if (!base.next(i >> 1, u)) return false; if (i & 1) { u.pm += dM; u.pn += dN; } return true; }
    __device__ __forceinline__ void a_ready(const Unit&) const {}
    __device__ __forceinline__ void done(const Unit&) const {}
};

__device__ __forceinline__ u32x4 pack8(const f32x4 a, const f32x4 b) { u32x4 w; w.x = cvtpk_s(a[0], a[1]); w.y = cvtpk_s(a[2], a[3]); w.z = cvtpk_s(b[0], b[1]); w.w = cvtpk_s(b[2], b[3]); return w; }
__device__ __forceinline__ void unpack8(const u32x4 w, f32x4& a, f32x4& b) { a[0] = bf_lo(w.x); a[1] = bf_hi(w.x); a[2] = bf_lo(w.y); a[3] = bf_hi(w.y); b[0] = bf_lo(w.z); b[1] = bf_hi(w.z); b[2] = bf_lo(w.w); b[3] = bf_hi(w.w); }

struct EpiIn {
    static constexpr bool PERM = true, AFTER_DRAIN = false, CHAIN = false;
    unsigned char* ws; float* out;
    __device__ __forceinline__ void operator()(f32x4 (&acc)[2][2][4][2], const Unit& u, int wr, int wc, int fr, int fq) const {
        bf16_t* const Q = (bf16_t*)(ws + WS_Q); bf16_t* const Kb = (bf16_t*)(ws + WS_K); bf16_t* const Vb = (bf16_t*)(ws + WS_V); bf16_t* const ZA = (bf16_t*)(ws + WS_ZA);
        bf16_t* const U = (bf16_t*)(ws + WS_U); bf16_t* const ZS = (bf16_t*)(ws + WS_ZS); bf16_t* const GA = (bf16_t*)(ws + WS_GA); bf16_t* const GS = (bf16_t*)(ws + WS_GS);
        const float* const rope = (const float*)(ws + WS_ROPE);
        const int pn = u.pn;
        const int rowb = u.pm * BM + wr * 64 + fr;
        const int cw = wc * 32 + 8 * fq;
        bf16_t* dst; int ld, cbase, mode;
        if (pn < 2)       { dst = Q;  ld = 512;  cbase = pn * 256;        mode = 3; }
        else if (pn == 2) { dst = Kb; ld = 128;  cbase = 0;               mode = 4; }
        else if (pn < 5)  { dst = ZA; ld = 512;  cbase = (pn - 3) * 256;  mode = 1; }
        else if (pn < 7)  { dst = U;  ld = 512;  cbase = (pn - 5) * 256;  mode = 0; }
        else if (pn < 9)  { dst = ZS; ld = 512;  cbase = (pn - 7) * 256;  mode = 1; }
        else if (pn < 13) { dst = GA; ld = 1024; cbase = (pn - 9) * 256;  mode = 2; }
        else              { dst = GS; ld = 1024; cbase = (pn - 13) * 256; mode = 2; }
        const bool ropew = ((wc & 1) == 0);
#pragma unroll
        for (int ai = 0; ai < 2; ++ai)
#pragma unroll
            for (int m = 0; m < 4; ++m) {
                const int row = rowb + ai * HALF + m * 16;
                const int pos = row < MP ? (row & (SEQ - 1)) : PAST + ((row - MP) & (DSEQ - 1));
#pragma unroll
                for (int bj = 0; bj < 2; ++bj) {
                    f32x4 v0 = acc[ai][bj][m][0], v1 = acc[ai][bj][m][1];
                    if (mode == 1) {
#pragma unroll
                        for (int j = 0; j < 4; ++j) { v0[j] = silu_f(v0[j]); v1[j] = silu_f(v1[j]); }
                    } else if (mode == 2) {
#pragma unroll
                        for (int j = 0; j < 4; ++j) { v0[j] = sigmoid_f(v0[j]); v1[j] = sigmoid_f(v1[j]); }
                    } else if (mode == 3 || (mode == 4 && bj == 0)) {
                        if (ropew) {
                            f32x4 p0, p1;
#pragma unroll
                            for (int j = 0; j < 4; ++j) { p0[j] = __shfl_xor(v0[j], 16); p1[j] = __shfl_xor(v1[j], 16); }
                            if (fq < 2) {
                                const f32x4* cs = (const f32x4*)(rope + (size_t)pos * 16);
                                const f32x4 c01 = cs[0], c23 = cs[1], c45 = cs[2], c67 = cs[3];
                                const float sg = fq == 0 ? -1.f : 1.f;
                                v0[0] = v0[0] * c01[0] + sg * p0[0] * c01[1]; v0[1] = v0[1] * c01[2] + sg * p0[1] * c01[3];
                                v0[2] = v0[2] * c23[0] + sg * p0[2] * c23[1]; v0[3] = v0[3] * c23[2] + sg * p0[3] * c23[3];
                                v1[0] = v1[0] * c45[0] + sg * p1[0] * c45[1]; v1[1] = v1[1] * c45[2] + sg * p1[1] * c45[3];
                                v1[2] = v1[2] * c67[0] + sg * p1[2] * c67[1]; v1[3] = v1[3] * c67[2] + sg * p1[3] * c67[3];
                            }
                        }
                    }
                    if (mode == 4) {
                        bf16_t* d2 = bj == 0 ? Kb : Vb;
                        *(u32x4*)(d2 + (size_t)row * 128 + cw) = pack8(v0, v1);
                        float* w = nullptr;
                        if (u.pm >= MP / BM) { const int rs = row - MP; w = out + (bj == 0 ? OFF_KS : OFF_VS) + ((size_t)((rs >> 6) * 128 + 64 + (rs & 63))) * 128 + cw; }
                        else if ((u.pm & 7) == 7 && ai == 1) { const int t = row & (SEQ - 1); w = out + (bj == 0 ? OFF_KP : OFF_VP) + ((size_t)((row >> 11) * 128 + (t - (SEQ - 128)))) * 128 + cw; }
                        if (w) { *(f32x4*)w = v0; *(f32x4*)(w + 4) = v1; }
                    } else {
                        *(u32x4*)(dst + (size_t)row * ld + cbase + bj * HALF + cw) = pack8(v0, v1);
                    }
                }
            }
    }
};

struct EpiMerge {
    static constexpr bool PERM = true, AFTER_DRAIN = false, CHAIN = true;
    unsigned char* ws;
    static constexpr int nMt = M / BM;
    __device__ __forceinline__ void operator()(f32x4 (&acc)[2][2][4][2], const Unit& u, int wr, int wc, int fr, int fq) const {
        const bf16_t* const GA = (const bf16_t*)(ws + WS_GA); const bf16_t* const GS = (const bf16_t*)(ws + WS_GS); bf16_t* const MG = (bf16_t*)(ws + WS_XN);
        const bool second = u.pn >= 4;
        const int pm = second ? u.pm - nMt : u.pm, pn = second ? u.pn - 4 : u.pn;
        const int rowb = pm * BM + wr * 64 + fr, colb = pn * BM + wc * 32 + 8 * fq;
#pragma unroll
        for (int ai = 0; ai < 2; ++ai)
#pragma unroll
            for (int m = 0; m < 4; ++m) {
                const size_t ro = (size_t)(rowb + ai * HALF + m * 16) * DM + colb;
#pragma unroll
                for (int bj = 0; bj < 2; ++bj) {
                    f32x4 s0, s1; unpack8(*(const u32x4*)(GS + ro + bj * HALF), s0, s1);
                    if (!second) {
                        f32x4 a0, a1; unpack8(*(const u32x4*)(GA + ro + bj * HALF), a0, a1);
#pragma unroll
                        for (int j = 0; j < 4; ++j) { acc[ai][bj][m][0][j] *= a0[j] * __builtin_amdgcn_rcpf(s0[j]); acc[ai][bj][m][1][j] *= a1[j] * __builtin_amdgcn_rcpf(s1[j]); }
                    } else {
                        *(u32x4*)(MG + ro + bj * HALF) = pack8(acc[ai][bj][m][0] * s0, acc[ai][bj][m][1] * s1);
                    }
                }
                asm volatile("" ::: "memory");
            }
    }
};

struct EpiH1 {
    static constexpr bool PERM = true, AFTER_DRAIN = false, CHAIN = false;
    const float *xp, *xs; float* out; unsigned char* ws;
    __device__ __forceinline__ void operator()(f32x4 (&acc)[2][2][4][2], const Unit& u, int wr, int wc, int fr, int fq) const {
        bf16_t* const H1B = (bf16_t*)(ws + WS_GA);
        const int rowb = u.pm * BM + wr * 64 + fr, colb = u.pn * BM + wc * 32 + 8 * fq;
        const float* xb = u.pm < MP / BM ? xp : xs - (size_t)MP * DM;
#pragma unroll
        for (int ai = 0; ai < 2; ++ai)
#pragma unroll
            for (int m = 0; m < 4; ++m) {
                const size_t ro = (size_t)(rowb + ai * HALF + m * 16) * DM + colb;
#pragma unroll
                for (int bj = 0; bj < 2; ++bj) {
                    const f32x4 h0 = *(const f32x4*)(xb + ro + bj * HALF) + acc[ai][bj][m][0], h1 = *(const f32x4*)(xb + ro + bj * HALF + 4) + acc[ai][bj][m][1];
                    *(f32x4*)(out + ro + bj * HALF) = h0; *(f32x4*)(out + ro + bj * HALF + 4) = h1;
                    *(u32x4*)(H1B + ro + bj * HALF) = pack8(h0, h1);
                }
                asm volatile("" ::: "memory");
            }
    }
};

struct EpiPP {
    static constexpr bool PERM = true, AFTER_DRAIN = false, CHAIN = false;
    unsigned char* ws;
    __device__ __forceinline__ void operator()(f32x4 (&acc)[2][2][4][2], const Unit& u, int wr, int wc, int fr, int fq) const {
        bf16_t* const PP = (bf16_t*)(ws + WS_GS);
        const int rowb = u.pm * BM + wr * 64 + fr, colb = u.pn * BM + wc * 32 + 8 * fq;
#pragma unroll
        for (int ai = 0; ai < 2; ++ai)
#pragma unroll
            for (int m = 0; m < 4; ++m) {
                const size_t ro = (size_t)(rowb + ai * HALF + m * 16) * DM + colb;
#pragma unroll
                for (int bj = 0; bj < 2; ++bj) *(u32x4*)(PP + ro + bj * HALF) = pack8(acc[ai][bj][m][0], acc[ai][bj][m][1]);
            }
    }
};

struct EpiH2 {
    static constexpr bool PERM = true, AFTER_DRAIN = false, CHAIN = false;
    float* out; unsigned char* ws;
    __device__ __forceinline__ void operator()(f32x4 (&acc)[2][2][4][2], const Unit& u, int wr, int wc, int fr, int fq) const {
        const bf16_t* const PP = (const bf16_t*)(ws + WS_GS); float* const ssq = (float*)(ws + WS_SSQ);
        const int rowb = u.pm * BM + wr * 64 + fr, colb = u.pn * BM + wc * 32 + 8 * fq;
#pragma unroll
        for (int ai = 0; ai < 2; ++ai)
#pragma unroll
            for (int m = 0; m < 4; ++m) {
                const int row = rowb + ai * HALF + m * 16;
                const size_t ro = (size_t)row * DM + colb;
                float sq = 0.f;
#pragma unroll
                for (int bj = 0; bj < 2; ++bj) {
                    f32x4 p0, p1; unpack8(*(const u32x4*)(PP + ro + bj * HALF), p0, p1);
                    f32x4 h0 = *(const f32x4*)(out + ro + bj * HALF), h1 = *(const f32x4*)(out + ro + bj * HALF + 4);
#pragma unroll
                    for (int j = 0; j < 4; ++j) { h0[j] += sigmoid_f(acc[ai][bj][m][0][j]) * p0[j]; h1[j] += sigmoid_f(acc[ai][bj][m][1][j]) * p1[j]; sq += h0[j] * h0[j] + h1[j] * h1[j]; }
                    *(f32x4*)(out + ro + bj * HALF) = h0; *(f32x4*)(out + ro + bj * HALF + 4) = h1;
                }
                sq += __shfl_xor(sq, 16); sq += __shfl_xor(sq, 32);
                if (fq == 0) ssq[(size_t)row * 16 + u.pn * 4 + wc] = sq;
                asm volatile("" ::: "memory");
            }
    }
};


struct EpiGLU {
    static constexpr bool PERM = true, AFTER_DRAIN = false, CHAIN = false;
    unsigned char* ws;
    __device__ __forceinline__ void operator()(f32x4 (&acc)[2][2][4][2], const Unit& u, int wr, int wc, int fr, int fq) const {
        const bf16_t* const Z = (const bf16_t*)(ws + WS_Z); const bf16_t* const ZS = (const bf16_t*)(ws + WS_ZS); bf16_t* const S1 = (bf16_t*)(ws + WS_AST) + (size_t)M * 512;
        const int rowb = u.pm * BM + wr * 64 + fr, colb = u.pn * BM + wc * 32 + 8 * fq;
#pragma unroll
        for (int ai = 0; ai < 2; ++ai)
#pragma unroll
            for (int m = 0; m < 4; ++m) {
                const size_t ro = (size_t)(rowb + ai * HALF + m * 16) * 512 + colb;
#pragma unroll
                for (int bj = 0; bj < 2; ++bj) {
                    f32x4 z0, z1, s0, s1; unpack8(*(const u32x4*)(Z + ro + bj * HALF), z0, z1); unpack8(*(const u32x4*)(ZS + ro + bj * HALF), s0, s1);
#pragma unroll
                    for (int j = 0; j < 4; ++j) { z0[j] *= sigmoid_f(acc[ai][bj][m][0][j]) * s0[j]; z1[j] *= sigmoid_f(acc[ai][bj][m][1][j]) * s1[j]; }
                    *(u32x4*)(S1 + ro + bj * HALF) = pack8(z0, z1);
                }
                asm volatile("" ::: "memory");
            }
    }
};
template <class Epi, class Sched, bool ALIGN_EPI = false, bool SP2 = false>
__device__ __forceinline__ void gemm_phase(PG8_LAS unsigned char* lds, const Gemm g, const Sched& S, const Epi& E) {
    int tid = threadIdx.x; asm volatile("" : "+v"(tid));
    const int wid = __builtin_amdgcn_readfirstlane(tid >> 6), lane = tid & 63, wr = wid >> 2, wc = wid & 3, fr = lane & 15, fq = lane >> 4;
    int K = g.K; asm volatile("" : "+s"(K));
    const int nt = K / BK;
    unsigned voffA[2], voffB[2];
#pragma unroll
    for (int i = 0; i < 2; ++i) { int R, C; stage_rc(tid * 16 + i * 8192, R, C); const int Rb = Epi::PERM ? ((R & ~31) + perm32(R & 31)) : R;
        voffA[i] = (unsigned)(R * K + C) * 2u; voffB[i] = (unsigned)(Rb * K + C) * 2u; }
    const size_t kstep = (size_t)(BK * 2);
    const size_t hstep = (size_t)HALF * K * 2;
    const size_t tstep = 2 * hstep;
    const unsigned ldsw = (unsigned)wid * 1024u;
    const int aoff = lds_byte(wr * 64 + fr, fq * 8), boff = lds_byte(wc * 32 + fr, fq * 8);
#define PG8_SA(b, h) (((b) * 2 + (h)) * HTB)
#define PG8_SB(b, h) ((4 + (b) * 2 + (h)) * HTB)
#define PG8_STAGE(bufoff, gbase, voff) do { _Pragma("unroll") for (int _i = 0; _i < 2; ++_i) \
        __builtin_amdgcn_global_load_lds((const unsigned*)((const char*)(gbase) + (voff)[_i]), (PG8_LAS unsigned*)(lds + (bufoff) + ldsw + _i * 8192), 16, 0, 0); } while (0)
#define PG8_LDA(dst, b, h) do { _Pragma("unroll") for (int m = 0; m < 4; ++m) _Pragma("unroll") for (int k = 0; k < 2; ++k) dst[m][k] = *(const PG8_LAS bf16x8*)(lds + PG8_SA(b, h) + aoff + m * 2048 + k * 1024); } while (0)
#define PG8_LDB(dst, b, h) do { _Pragma("unroll") for (int n = 0; n < 2; ++n) _Pragma("unroll") for (int k = 0; k < 2; ++k) dst[n][k] = *(const PG8_LAS bf16x8*)(lds + PG8_SB(b, h) + boff + n * 2048 + k * 1024); } while (0)
#define PG8_MMA(ai, bj, At, Bt) do { __builtin_amdgcn_s_setprio(1); _Pragma("unroll") for (int m = 0; m < 4; ++m) _Pragma("unroll") for (int n = 0; n < 2; ++n) _Pragma("unroll") for (int k = 0; k < 2; ++k) \
        acc[ai][bj][m][n] = __builtin_amdgcn_mfma_f32_16x16x32_bf16(Bt[n][k], At[m][k], acc[ai][bj][m][n], 0, 0, 0); __builtin_amdgcn_s_setprio(0); } while (0)
#define PG8_WAIT_V(n) asm volatile("s_waitcnt vmcnt(" #n ")" ::: "memory")
#define PG8_WAIT_L(n) asm volatile("s_waitcnt lgkmcnt(" #n ")" ::: "memory")
#define PG8_BAR __builtin_amdgcn_s_barrier()
#define PG8_SCHED __builtin_amdgcn_sched_barrier(0)
    Unit cur, nxt; int ui = 0;
    if (!S.next(0, cur)) return;
    f32x4 acc[2][2][4][2];
#pragma unroll
    for (int a = 0; a < 2; ++a)
#pragma unroll
        for (int b = 0; b < 2; ++b)
#pragma unroll
            for (int m = 0; m < 4; ++m)
#pragma unroll
                for (int n = 0; n < 2; ++n) acc[a][b][m][n] = (f32x4){0.f, 0.f, 0.f, 0.f};
    bf16x8 At[4][2], B0[2][2], B1[2][2];
    const char* cA = (const char*)g.A + (size_t)cur.pm * tstep; const char* cB = (const char*)g.Bt + (size_t)cur.pn * tstep;
    S.a_ready(cur);
    if constexpr (SP2) {
        PG8_STAGE(PG8_SB(0, 0), cB, voffB); PG8_STAGE(PG8_SB(0, 1), cB + hstep, voffB); PG8_STAGE(PG8_SA(0, 0), cA, voffA); PG8_STAGE(PG8_SA(0, 1), cA + hstep, voffA);
        if (wr == 1) PG8_BAR;
        PG8_WAIT_V(2); PG8_BAR;
        PG8_STAGE(PG8_SB(1, 0), cB + kstep, voffB); PG8_STAGE(PG8_SA(1, 0), cA + kstep, voffA); PG8_STAGE(PG8_SB(1, 1), cB + hstep + kstep, voffB);
        PG8_WAIT_V(6); PG8_BAR;
    } else {
        PG8_STAGE(PG8_SB(0, 0), cB, voffB); PG8_STAGE(PG8_SA(0, 0), cA, voffA); PG8_STAGE(PG8_SB(0, 1), cB + hstep, voffB); PG8_STAGE(PG8_SA(0, 1), cA + hstep, voffA);
        if (wr == 1) PG8_BAR;
        PG8_WAIT_V(4); PG8_BAR;
        PG8_STAGE(PG8_SB(1, 0), cB + kstep, voffB); PG8_STAGE(PG8_SA(1, 0), cA + kstep, voffA); PG8_STAGE(PG8_SB(1, 1), cB + hstep + kstep, voffB);
        PG8_WAIT_V(6); PG8_BAR;
    }
    for (;;) {
        const bool has_next = S.next(ui + 1, nxt);
        const char* nA = has_next ? (const char*)g.A + (size_t)nxt.pm * tstep : cA; const char* nB = has_next ? (const char*)g.Bt + (size_t)nxt.pn * tstep : cB;
        for (int t = 0; t < nt; t += 2) {
            const bool last = (t == nt - 2);
            const char* a1 = cA + (size_t)(t + 1) * kstep;
            const char* a2 = last ? nA : cA + (size_t)(t + 2) * kstep; const char* b2 = last ? nB : cB + (size_t)(t + 2) * kstep;
            const char* a3 = a2 + kstep; const char* b3 = b2 + kstep;
            if (last && has_next) S.a_ready(nxt);
            if constexpr (SP2) {
            PG8_LDB(B0, 0, 0); PG8_LDB(B1, 0, 1); PG8_SCHED; PG8_LDA(At, 0, 0); PG8_STAGE(PG8_SA(1, 1), a1 + hstep, voffA);
            PG8_WAIT_V(8); PG8_WAIT_L(0); PG8_BAR; PG8_MMA(0, 0, At, B0); PG8_MMA(0, 1, At, B1); PG8_BAR; PG8_SCHED;
            PG8_LDA(At, 0, 1); PG8_STAGE(PG8_SB(0, 0), b2, voffB); PG8_STAGE(PG8_SB(0, 1), b2 + hstep, voffB); PG8_STAGE(PG8_SA(0, 0), a2, voffA);
            PG8_WAIT_V(8); PG8_WAIT_L(0); PG8_BAR; PG8_MMA(1, 0, At, B0); PG8_MMA(1, 1, At, B1); PG8_BAR; PG8_SCHED;
            PG8_LDB(B0, 1, 0); PG8_LDB(B1, 1, 1); PG8_SCHED; PG8_LDA(At, 1, 0); PG8_STAGE(PG8_SA(0, 1), a2 + hstep, voffA);
            PG8_WAIT_V(8); PG8_WAIT_L(0); PG8_BAR; PG8_MMA(0, 0, At, B0); PG8_MMA(0, 1, At, B1); PG8_BAR; PG8_SCHED;
            PG8_LDA(At, 1, 1); PG8_STAGE(PG8_SB(1, 0), b3, voffB); PG8_STAGE(PG8_SB(1, 1), b3 + hstep, voffB); PG8_STAGE(PG8_SA(1, 0), a3, voffA);
            PG8_WAIT_V(8); PG8_WAIT_L(0); PG8_BAR; PG8_MMA(1, 0, At, B0); PG8_MMA(1, 1, At, B1); PG8_BAR; PG8_SCHED;
            } else {
            PG8_LDB(B0, 0, 0); PG8_SCHED; PG8_LDA(At, 0, 0); PG8_STAGE(PG8_SA(1, 1), a1 + hstep, voffA);
            PG8_WAIT_L(8); PG8_BAR; PG8_WAIT_L(0); PG8_MMA(0, 0, At, B0); PG8_BAR; PG8_SCHED;
            PG8_LDB(B1, 0, 1); PG8_STAGE(PG8_SB(0, 0), b2, voffB);
            PG8_BAR; PG8_WAIT_L(0); PG8_MMA(0, 1, At, B1); PG8_BAR;
            PG8_LDA(At, 0, 1); PG8_STAGE(PG8_SA(0, 0), a2, voffA);
            PG8_BAR; PG8_WAIT_L(0); PG8_MMA(1, 0, At, B0); PG8_BAR; PG8_SCHED;
            PG8_STAGE(PG8_SB(0, 1), b2 + hstep, voffB);
            PG8_WAIT_V(6); PG8_BAR; PG8_MMA(1, 1, At, B1); PG8_BAR;
            PG8_LDB(B0, 1, 0); PG8_SCHED; PG8_LDA(At, 1, 0); PG8_STAGE(PG8_SA(0, 1), a2 + hstep, voffA);
            PG8_WAIT_L(8); PG8_BAR; PG8_WAIT_L(0); PG8_MMA(0, 0, At, B0); PG8_BAR; PG8_SCHED;
            PG8_LDB(B1, 1, 1); PG8_STAGE(PG8_SB(1, 0), b3, voffB);
            PG8_BAR; PG8_WAIT_L(0); PG8_MMA(0, 1, At, B1); PG8_BAR;
            PG8_LDA(At, 1, 1); PG8_STAGE(PG8_SA(1, 0), a3, voffA);
            PG8_BAR; PG8_WAIT_L(0); PG8_MMA(1, 0, At, B0); PG8_BAR; PG8_SCHED;
            PG8_STAGE(PG8_SB(1, 1), b3 + hstep, voffB);
            PG8_WAIT_V(6); PG8_BAR; PG8_MMA(1, 1, At, B1); PG8_BAR;
            }
        }
        if constexpr (ALIGN_EPI) { if (wr == 0) PG8_BAR; }
        if constexpr (!Epi::AFTER_DRAIN) { E(acc, cur, wr, wc, fr, fq); S.done(cur); }
        if (!has_next) break;
        if (!(Epi::CHAIN && (ui & 1) == 0)) {
#pragma unroll
        for (int a = 0; a < 2; ++a)
#pragma unroll
            for (int b = 0; b < 2; ++b)
#pragma unroll
                for (int m = 0; m < 4; ++m)
#pragma unroll
                    for (int n = 0; n < 2; ++n) acc[a][b][m][n] = (f32x4){0.f, 0.f, 0.f, 0.f};
        }
        cur = nxt; cA = nA; cB = nB; ++ui;
        if constexpr (ALIGN_EPI) { if (wr == 1) PG8_BAR; }
    }
    PG8_WAIT_V(0);
    if constexpr (!ALIGN_EPI) { if (wr == 0) PG8_BAR; }
    PG8_BAR;
    if constexpr (Epi::AFTER_DRAIN) { E.fused(acc, cur, wr, wc, fr, fq, lds, wid, lane); S.done(cur); }
#undef PG8_SA
#undef PG8_SB
#undef PG8_STAGE
#undef PG8_LDA
#undef PG8_LDB
#undef PG8_MMA
#undef PG8_WAIT_V
#undef PG8_WAIT_L
#undef PG8_BAR
#undef PG8_SCHED
}
}


constexpr int NWAVES = 8;
#ifndef MK_N_LAUNCHES
#define MK_N_LAUNCHES 1
#endif
constexpr int N_PHASES = 9;
constexpr int N_LAUNCHES = MK_N_LAUNCHES;

constexpr int RING_BYTES = 131072;
constexpr int KL_STRIDE = 144, VT_STRIDE = 400;
constexpr int LDS_KL = 0, LDS_VT = 192 * KL_STRIDE;
constexpr int ZL_STRIDE = 1040, HL_STRIDE = 272;
constexpr int LDS_ZL = 0, LDS_HL = 64 * ZL_STRIDE  , HL_WAVE = 32 * HL_STRIDE  , LDS_HP = LDS_HL + NWAVES * HL_WAVE  , LDS_P3_END = LDS_HP + 16384  ;
constexpr int MISC_OFF = LDS_P3_END;
constexpr int LDS_BYTES = 153600;
static_assert(MISC_OFF + 512 <= LDS_BYTES && LDS_VT + 64 * VT_STRIDE <= RING_BYTES, "LDS map");

#define GAS __attribute__((address_space(1)))
#define LAS __attribute__((address_space(3)))
typedef unsigned short bf16;
typedef unsigned v4u __attribute__((ext_vector_type(4)));
typedef unsigned v2u __attribute__((ext_vector_type(2)));
typedef float f32x4 __attribute__((ext_vector_type(4)));
typedef float f32x16 __attribute__((ext_vector_type(16)));
typedef short bf16x8 __attribute__((ext_vector_type(8)));
typedef GAS unsigned gu32;
#define RLX_AGENT __ATOMIC_RELAXED, __HIP_MEMORY_SCOPE_AGENT
#define LDS_WAIT() asm volatile("s_waitcnt lgkmcnt(0)" ::: "memory")
#define VM_WAIT() asm volatile("s_waitcnt vmcnt(0)" ::: "memory")
__device__ __forceinline__ unsigned pk2(float lo, float hi) { return cvtpk_s(lo, hi); }
__device__ __forceinline__ bf16 f2bf(float f) { return (bf16)(cvtpk_s(f, 0.f) & 0xffffu); }

#define XB_TMO      128
#define XB_XCNT(j)  (256  + 64 * (j))
#define XB_XSUB(j)  (1280 + 64 * (j))
#define XB_XGEN(j)  (2304 + 64 * (j))
#define XB_TOP      3328
#define XB_TOPGEN   3392
#define XCD_BAR_WORDS 3456
#define XB_SPIN_CAP (1u << 18)

__device__ __forceinline__ unsigned xb_ld(unsigned* p)              { return __hip_atomic_load(p, __ATOMIC_RELAXED, __HIP_MEMORY_SCOPE_AGENT); }
__device__ __forceinline__ unsigned xb_add(unsigned* p, unsigned v) { return __hip_atomic_fetch_add(p, v, __ATOMIC_RELAXED, __HIP_MEMORY_SCOPE_AGENT); }
__device__ __forceinline__ unsigned xb_xcc_id() { return (unsigned)__builtin_amdgcn_s_getreg((3 << 11) | 20) & 0xFu; }
#define XB_SPIN(cond, bar) do { unsigned _sp = 0; while (cond) { __builtin_amdgcn_s_sleep(1); \
    if ((++_sp & 255u) == 0u) { if (xb_ld(&(bar)[XB_TMO])) break; if (_sp > XB_SPIN_CAP) { atomicAdd(&(bar)[XB_TMO], 1u); break; } } } } while (0)

struct XcdBarrier { unsigned* bar; unsigned x; volatile LAS unsigned* st; };

__device__ __forceinline__ XcdBarrier xcd_barrier_post(unsigned* bar, volatile LAS unsigned* st) {
    XcdBarrier b; b.bar = bar; b.x = xb_xcc_id(); b.st = st;
    if (threadIdx.x == 0) (void)xb_add(&bar[XB_XCNT(b.x)], 1u);
    return b;
}
__device__ __forceinline__ void xcd_barrier_complete(unsigned* bar, unsigned x, unsigned& nloc, unsigned& nx) {
    const unsigned G = gridDim.x * gridDim.y * gridDim.z;
    unsigned sum, cnt, mine, sp = 0u;
    for (;;) {
        sum = 0u; cnt = 0u; mine = 0u;
#pragma unroll
        for (unsigned j = 0; j < 16; ++j) { const unsigned c = xb_ld(&bar[XB_XCNT(j)]); sum += c; cnt += (c > 0u) ? 1u : 0u; mine = (j == x) ? c : mine; }
        if (sum == G) break;
        __builtin_amdgcn_s_sleep(1);
        if ((++sp & 255u) == 0u) { if (xb_ld(&bar[XB_TMO])) break; if (sp > XB_SPIN_CAP) { atomicAdd(&bar[XB_TMO], 1u); break; } }
    }
    nloc = mine > 0u ? mine : 1u; nx = cnt > 0u ? cnt : 1u;
}
__device__ __forceinline__ void xcd_barrier(const XcdBarrier& b) {
    asm volatile("s_waitcnt vmcnt(0)" ::: "memory");
    __syncthreads();
    if (threadIdx.x == 0) {
        unsigned* bar = b.bar;
        __builtin_amdgcn_s_waitcnt(0);
        unsigned nloc = b.st[0], nx = b.st[1];
        if (nloc == 0u) { xcd_barrier_complete(bar, b.x, nloc, nx); b.st[0] = nloc; b.st[1] = nx; }
        const unsigned old = xb_add(&bar[XB_XSUB(b.x)], 1u);
        const unsigned gen = old / nloc;
        if (old + 1u == (gen + 1u) * nloc) {
            __builtin_amdgcn_fence(__ATOMIC_RELEASE, "agent");
            asm volatile("s_waitcnt vmcnt(0)" ::: "memory");
            const unsigned og = xb_add(&bar[XB_TOP], 1u);
            const unsigned tg = og / nx;
            if (og + 1u == (tg + 1u) * nx) xb_add(&bar[XB_TOPGEN], 1u);
            else XB_SPIN(xb_ld(&bar[XB_TOPGEN]) == tg, bar);
            __builtin_amdgcn_fence(__ATOMIC_ACQUIRE, "agent");
            xb_add(&bar[XB_XGEN(b.x)], 1u);
            asm volatile("s_waitcnt vmcnt(0)" ::: "memory");
        } else {
            XB_SPIN(xb_ld(&bar[XB_XGEN(b.x)]) == gen, bar);
            __builtin_amdgcn_fence(__ATOMIC_ACQUIRE, "agent");
            asm volatile("s_waitcnt vmcnt(0)" ::: "memory");
        }
    }
    __syncthreads();
}

struct Args {
    const float *x_prompt, *x_sample, *p_prompt, *p_sample, *cache_k, *cache_v, *st_re, *st_im, *norm_gain, *w_in, *sinks, *w_o_attn,
                *a_re, *a_im, *log_dt, *b_re, *b_im, *c_re, *c_im, *ssm_d, *w_glu, *w_o_ssm, *w_out, *w_pg, *w_pp, *fgain;
    float* out; unsigned char* ws; int ph_lo, ph_hi;
};
typedef const __attribute__((address_space(4))) Args* AP;
__device__ __forceinline__ AP args_ptr() { AP p = (AP)__builtin_amdgcn_kernarg_segment_ptr(); asm volatile("" : "+s"(p)); return p; }

__device__ __forceinline__ float wave_sum(float v) {
#pragma unroll
    for (int o = 1; o < 64; o <<= 1) v += __shfl_xor(v, o);
    return v;
}
__device__ __forceinline__ void p0_transpose_item(const float* W, int K, int N, bf16* WT, int row_off, LAS float* scr, int item, int lane) {
    const int nblk = N / 32, kb = item / nblk, nb = item % nblk, k0 = 64 * kb, n0 = 32 * nb;
    float wv[32];
#pragma unroll
    for (int i = 0; i < 32; ++i) wv[i] = W[(size_t)(k0 + 2 * i + (lane >> 5)) * N + n0 + (lane & 31)];
#pragma unroll
    for (int i = 0; i < 32; ++i) scr[(2 * i + (lane >> 5)) * 33 + (lane & 31)] = wv[i];
    LDS_WAIT(); asm volatile("" ::: "memory");
    const int c = lane & 7;
#pragma unroll
    for (int j = 0; j < 4; ++j) { const int n = (lane >> 3) + 8 * j; const LAS float* s = scr + (8 * c) * 33 + n;
        v4u o; o.x = pk2(s[0 * 33], s[1 * 33]); o.y = pk2(s[2 * 33], s[3 * 33]); o.z = pk2(s[4 * 33], s[5 * 33]); o.w = pk2(s[6 * 33], s[7 * 33]);
        *(GAS v4u*)(WT + (size_t)(row_off + n0 + n) * K + k0 + 8 * c) = o; }
    LDS_WAIT(); asm volatile("" ::: "memory");
}
__device__ __forceinline__ void rms_row_to_bf16(const float* xrow, const float* gain, bf16* orow, int lane) {
    const GAS f32x4* xr = (const GAS f32x4*)xrow + lane; const GAS f32x4* gr = (const GAS f32x4*)gain + lane;
    f32x4 v[4]; float s = 0.f;
#pragma unroll
    for (int j = 0; j < 4; ++j) { v[j] = xr[64 * j]; s += (v[j].x * v[j].x + v[j].y * v[j].y) + (v[j].z * v[j].z + v[j].w * v[j].w); }
    const float r = 1.f / sqrtf(wave_sum(s) * (1.f / DM) + EPS);
    GAS v2u* o8 = (GAS v2u*)orow + lane;
#pragma unroll
    for (int j = 0; j < 4; ++j) { const f32x4 g = gr[64 * j]; v2u o; o.x = pk2(v[j].x * r * g.x, v[j].y * r * g.y); o.y = pk2(v[j].z * r * g.z, v[j].w * r * g.w); o8[64 * j] = o; }
}
__device__ __forceinline__ void sincos_d(double x, double& s, double& c) {
    const double k = __builtin_rint(x * 0.63661977236758134);
    double r = __builtin_fma(-k, 1.5707963267948966, x); r = __builtin_fma(-k, 6.123233995736766e-17, r);
    const int q = ((int)k) & 3;
    const double r2 = r * r;
    double sp = 1.0 / 355687428096000.0;
    sp = sp * r2 - 1.0 / 1307674368000.0; sp = sp * r2 + 1.0 / 6227020800.0; sp = sp * r2 - 1.0 / 39916800.0; sp = sp * r2 + 1.0 / 362880.0;
    sp = sp * r2 - 1.0 / 5040.0; sp = sp * r2 + 1.0 / 120.0; sp = sp * r2 - 1.0 / 6.0; sp = sp * r2 + 1.0; sp = sp * r;
    double cp = 1.0 / 20922789888000.0;
    cp = cp * r2 - 1.0 / 87178291200.0; cp = cp * r2 + 1.0 / 479001600.0; cp = cp * r2 - 1.0 / 3628800.0; cp = cp * r2 + 1.0 / 40320.0;
    cp = cp * r2 - 1.0 / 720.0; cp = cp * r2 + 1.0 / 24.0; cp = cp * r2 - 0.5; cp = cp * r2 + 1.0;
    s = (q == 0) ? sp : (q == 1) ? cp : (q == 2) ? -sp : -cp;
    c = (q == 0) ? cp : (q == 1) ? -sp : (q == 2) ? -cp : sp;
}
__device__ __forceinline__ double exp_d(double x) {
    const double k = __builtin_rint(x * 1.4426950408889634);
    double r = __builtin_fma(-k, 0.6931471805599453, x); r = __builtin_fma(-k, 2.3190468138462996e-17, r);
    double p = 1.0 / 6227020800.0;
    p = p * r + 1.0 / 479001600.0; p = p * r + 1.0 / 39916800.0; p = p * r + 1.0 / 3628800.0; p = p * r + 1.0 / 362880.0; p = p * r + 1.0 / 40320.0; p = p * r + 1.0 / 5040.0;
    p = p * r + 1.0 / 720.0; p = p * r + 1.0 / 120.0; p = p * r + 1.0 / 24.0; p = p * r + 1.0 / 6.0; p = p * r + 0.5; p = p * r + 1.0; p = p * r + 1.0;
    const long long bits = (long long)(1023 + (int)k) << 52;
    return p * __builtin_bit_cast(double, bits);
}
__device__ __forceinline__ double expm1_small_d(double x) {
    double p = 1.0 / 479001600.0;
    p = p * x + 1.0 / 39916800.0; p = p * x + 1.0 / 3628800.0; p = p * x + 1.0 / 362880.0; p = p * x + 1.0 / 40320.0; p = p * x + 1.0 / 5040.0;
    p = p * x + 1.0 / 720.0; p = p * x + 1.0 / 120.0; p = p * x + 1.0 / 24.0; p = p * x + 1.0 / 6.0; p = p * x + 0.5; p = p * x + 1.0;
    return p * x;
}

__device__ __forceinline__ void p0_prologue(AP a, LAS unsigned char* lds, int wave, int lane) {
    unsigned char* ws = a->ws;
    LAS float* scr = (LAS float*)(lds + wave * 16384);
    const int gw = blockIdx.x * NWAVES + wave, NGW = gridDim.x * NWAVES;
    const int gt = gw * 64 + lane, NGT = NGW * 64;
    constexpr int I_IN = (1024 / 64) * (INW / 32), I_OA = (512 / 64) * (1024 / 32), I_OS = I_OA, I_GL = (512 / 64) * (512 / 32), I_OUT = (1024 / 64) * (1024 / 32), I_PG = I_OUT, I_PP = (256 / 64) * (1024 / 32);
    constexpr int NITEMS = I_IN + I_OA + I_OS + I_GL + I_OUT + I_PG + I_PP;
    for (int it = gw; it < NITEMS; it += NGW) {
        int r = it;
        if (r < I_IN)  { p0_transpose_item(a->w_in, 1024, INW, (bf16*)(ws + WS_WIN), 0, scr, r, lane); continue; } r -= I_IN;
        if (r < I_OA)  { p0_transpose_item(a->w_o_attn, 512, 1024, (bf16*)(ws + WS_WST), 0, scr, r, lane); continue; } r -= I_OA;
        if (r < I_OS)  { p0_transpose_item(a->w_o_ssm, 512, 1024, (bf16*)(ws + WS_WST), 1024, scr, r, lane); continue; } r -= I_OS;
        if (r < I_GL)  { p0_transpose_item(a->w_glu, 512, 512, (bf16*)(ws + WS_WGLU), 0, scr, r, lane); continue; } r -= I_GL;
        if (r < I_OUT) { p0_transpose_item(a->w_out, 1024, 1024, (bf16*)(ws + WS_WOUT), 0, scr, r, lane); continue; } r -= I_OUT;
        if (r < I_PG)  { p0_transpose_item(a->w_pg, 1024, 1024, (bf16*)(ws + WS_WPG), 0, scr, r, lane); continue; } r -= I_PG;
        p0_transpose_item(a->w_pp, 256, 1024, (bf16*)(ws + WS_WPP), 0, scr, r, lane);
    }
    for (int m0 = gw; m0 < M; m0 += 2 * NGW) {
        const int m1 = m0 + NGW;
        const float* xr0 = m0 < MP ? a->x_prompt + (size_t)m0 * DM : a->x_sample + (size_t)(m0 - MP) * DM;
        const float* pr0 = m0 < MP ? a->p_prompt + (size_t)m0 * PLE : a->p_sample + (size_t)(m0 - MP) * PLE;
        const bool two = m1 < M;
        const int m1c = two ? m1 : m0;
        const float* xr1 = m1c < MP ? a->x_prompt + (size_t)m1c * DM : a->x_sample + (size_t)(m1c - MP) * DM;
        const float* pr1 = m1c < MP ? a->p_prompt + (size_t)m1c * PLE : a->p_sample + (size_t)(m1c - MP) * PLE;
        f32x4 v0[4], v1[4];
#pragma unroll
        for (int j = 0; j < 4; ++j) { v0[j] = ((const GAS f32x4*)xr0)[lane + 64 * j]; v1[j] = ((const GAS f32x4*)xr1)[lane + 64 * j]; }
        const f32x4 pv0 = ((const GAS f32x4*)pr0)[lane], pv1 = ((const GAS f32x4*)pr1)[lane];
        float s0 = 0.f, s1 = 0.f;
#pragma unroll
        for (int j = 0; j < 4; ++j) { s0 += (v0[j].x * v0[j].x + v0[j].y * v0[j].y) + (v0[j].z * v0[j].z + v0[j].w * v0[j].w); s1 += (v1[j].x * v1[j].x + v1[j].y * v1[j].y) + (v1[j].z * v1[j].z + v1[j].w * v1[j].w); }
        const float r0 = 1.f / sqrtf(wave_sum(s0) * (1.f / DM) + EPS), r1 = 1.f / sqrtf(wave_sum(s1) * (1.f / DM) + EPS);
        GAS v2u* o0 = (GAS v2u*)((bf16*)(ws + WS_XN) + (size_t)m0 * DM) + lane; GAS v2u* o1 = (GAS v2u*)((bf16*)(ws + WS_XN) + (size_t)m1c * DM) + lane;
#pragma unroll
        for (int j = 0; j < 4; ++j) {
            const f32x4 g = ((const GAS f32x4*)a->norm_gain)[lane + 64 * j];
            v2u o; o.x = pk2(v0[j].x * r0 * g.x, v0[j].y * r0 * g.y); o.y = pk2(v0[j].z * r0 * g.z, v0[j].w * r0 * g.w); o0[64 * j] = o;
            if (two) { v2u q; q.x = pk2(v1[j].x * r1 * g.x, v1[j].y * r1 * g.y); q.y = pk2(v1[j].z * r1 * g.z, v1[j].w * r1 * g.w); o1[64 * j] = q; }
        }
        { v2u o; o.x = pk2(pv0.x, pv0.y); o.y = pk2(pv0.z, pv0.w); ((GAS v2u*)((bf16*)(ws + WS_P) + (size_t)m0 * PLE))[lane] = o; }
        if (two) { v2u o; o.x = pk2(pv1.x, pv1.y); o.y = pk2(pv1.z, pv1.w); ((GAS v2u*)((bf16*)(ws + WS_P) + (size_t)m1c * PLE))[lane] = o; }
    }
    for (int i = gt; i < 2 * 16384; i += NGT) {
        const int which = i >> 14, j = i & 16383, b = j >> 11, r = j & 2047;
        const float* src = (which ? a->cache_v : a->cache_k) + (size_t)b * 16384 + 8192;
        float* dst = a->out + (which ? OFF_VS : OFF_KS) + (size_t)b * 16384;
        ((GAS f32x4*)dst)[r] = ((const GAS f32x4*)src)[r];
    }
    for (int i = gt; i < 2048 * 8; i += NGT) {
        const int pos = i >> 3, f = i & 7;
        const double INV[8] = {1.0, 0.19392274474868576, 0.03760603093086393, 0.007292664737217109, 0.001414213562373095, 0.0002742481756762073, 5.318295896944988e-05, 1.031338537721246e-05};
        double inv = INV[0];
#pragma unroll
        for (int q = 1; q < 8; ++q) inv = (f == q) ? INV[q] : inv;
        const float ang = (float)pos * (float)inv;
        double s, c; sincos_d((double)ang, s, c);
        float* rt = (float*)(ws + WS_ROPE) + (size_t)i * 2; rt[0] = (float)c; rt[1] = (float)s;
    }
    for (int it = gt; it < 32 * 64; it += NGT) {
        const int g = it >> 6, p = it & 63;
        const double lr = (double)a->a_re[it], li = (double)a->a_im[it], dt = exp_d((double)a->log_dt[g]);
        const double xr = lr * dt, th = li * dt;
        double sn, cs, sh, ch; sincos_d(th, sn, cs); sincos_d(0.5 * th, sh, ch);
        const double em1 = expm1_small_d(xr), ex = em1 + 1.0;
        const double ar = ex * cs, ai = ex * sn;
        const double ur = em1 * cs - 2.0 * sh * sh, ui = ai;
        const double den = lr * lr + li * li;
        const double cr = (ur * lr + ui * li) / den, ci = (ui * lr - ur * li) / den;
        bf16* Bb = (bf16*)(ws + WS_SSMB);
#pragma unroll
        for (int c = 0; c < 16; ++c) {
            const double br = (double)a->b_re[(size_t)it * 16 + c], bi = (double)a->b_im[(size_t)it * 16 + c];
            Bb[(size_t)(g * 128 + p) * 16 + c] = f2bf((float)(cr * br - ci * bi));
            Bb[(size_t)(g * 128 + 64 + p) * 16 + c] = f2bf((float)(cr * bi + ci * br));
        }
        bf16* Cm = (bf16*)(ws + WS_SSMC);
        const int kq = 4 * (p & 31) + 2 * (p >> 5);
#pragma unroll
        for (int co = 0; co < 16; ++co) {
            Cm[(size_t)(g * 16 + co) * 128 + kq] = f2bf(a->c_re[(size_t)(g * 16 + co) * 64 + p]);
            Cm[(size_t)(g * 16 + co) * 128 + kq + 1] = f2bf(-a->c_im[(size_t)(g * 16 + co) * 64 + p]);
        }
        float* ap = (float*)(ws + WS_APOW) + (size_t)it * 12;
        const double a2r = ar * ar - ai * ai, a2i = 2.0 * ar * ai;
        const double a3r = a2r * ar - a2i * ai, a3i = a2r * ai + a2i * ar;
        const double a4r = a2r * a2r - a2i * a2i, a4i = 2.0 * a2r * a2i;
        const double a8r = a4r * a4r - a4i * a4i, a8i = 2.0 * a4r * a4i;
        double pr = a8r, pi = a8i;
#pragma unroll
        for (int q = 0; q < 3; ++q) { const double t = pr * pr - pi * pi; pi = 2.0 * pr * pi; pr = t; }
        ap[0] = (float)ar; ap[1] = (float)ai; ap[2] = (float)a2r; ap[3] = (float)a2i; ap[4] = (float)a3r; ap[5] = (float)a3i;
        ap[6] = (float)a4r; ap[7] = (float)a4i; ap[8] = (float)a8r; ap[9] = (float)a8i; ap[10] = (float)pr; ap[11] = (float)pi;
#pragma unroll
        for (int q = 0; q < 2; ++q) { const double t = pr * pr - pi * pi; pi = 2.0 * pr * pi; pr = t; }
        float* a256 = (float*)(ws + WS_APOW256) + (size_t)it * 2; a256[0] = (float)pr; a256[1] = (float)pi;
    }
}

#define MFMA32(a, b, c) __builtin_amdgcn_mfma_f32_32x32x16_bf16((a), (b), (c), 0, 0, 0)
#define MFMA16(a, b, c) __builtin_amdgcn_mfma_f32_16x16x32_bf16((a), (b), (c), 0, 0, 0)
__device__ __forceinline__ bf16x8 pack_regs8(const f32x16& x, const int s) {
    v4u p; p.x = cvtpk_s(x[8 * s + 0], x[8 * s + 1]); p.y = cvtpk_s(x[8 * s + 2], x[8 * s + 3]); p.z = cvtpk_s(x[8 * s + 4], x[8 * s + 5]); p.w = cvtpk_s(x[8 * s + 6], x[8 * s + 7]);
    return __builtin_bit_cast(bf16x8, p);
}
__device__ __forceinline__ void attn_unit(AP a, LAS unsigned char* lds, int unit, int tid, int wave, int lane) {
    asm volatile("" : "+v"(tid), "+v"(lane));
    unsigned char* ws = a->ws;
    const bf16* Qb = (const bf16*)(ws + WS_Q); const bf16* Kb = (const bf16*)(ws + WS_K); const bf16* Vb = (const bf16*)(ws + WS_V);
    const bf16* ZA = (const bf16*)(ws + WS_ZA); bf16* A1 = (bf16*)(ws + WS_AST);
    const int kvh = unit & 1;
    const bool smp = unit >= 512;
    const int cr = smp ? 256 + ((unit - 512) >> 1) : (unit >> 1);
    const int row0 = cr * 64, c = cr & 31;
    const int kb_lo = smp ? 0 : (c >= 2 ? 0 : (2 - c) * 2);
#pragma unroll
    for (int i = 0; i < 3; ++i) {
        const int q = tid + 512 * i, key = q >> 3, ch = q & 7;
        v4u kv = {0u, 0u, 0u, 0u}, vv = {0u, 0u, 0u, 0u};
        if (smp) {
            if (key < 128) {
                const size_t o = ((size_t)((cr - 256) * 128 + key) * 2 + kvh) * 64 + ch * 8;
                const f32x4 k0 = *(const GAS f32x4*)(a->cache_k + o), k1 = *(const GAS f32x4*)(a->cache_k + o + 4);
                const f32x4 v0 = *(const GAS f32x4*)(a->cache_v + o), v1 = *(const GAS f32x4*)(a->cache_v + o + 4);
                kv.x = pk2(k0.x, k0.y); kv.y = pk2(k0.z, k0.w); kv.z = pk2(k1.x, k1.y); kv.w = pk2(k1.z, k1.w);
                vv.x = pk2(v0.x, v0.y); vv.y = pk2(v0.z, v0.w); vv.z = pk2(v1.x, v1.y); vv.w = pk2(v1.z, v1.w);
            } else {
                const size_t o = (size_t)(row0 + key - 128) * 128 + kvh * 64 + ch * 8;
                kv = *(const GAS v4u*)(Kb + o); vv = *(const GAS v4u*)(Vb + o);
            }
        } else {
            const int kc = key >> 6;
            if (c - 2 + kc >= 0) {
                const size_t o = (size_t)(row0 + (kc - 2) * 64 + (key & 63)) * 128 + kvh * 64 + ch * 8;
                kv = *(const GAS v4u*)(Kb + o); vv = *(const GAS v4u*)(Vb + o);
            }
        }
        *(LAS v4u*)(lds + LDS_KL + key * KL_STRIDE + ch * 16) = kv;
        const int w = key & 15, pos = (key & ~15) | (w & 3) | ((w & 4) << 1) | ((w & 8) >> 1);
        LAS bf16* vt = (LAS bf16*)(lds + LDS_VT) + pos;
        const int d0 = ch * 8;
        vt[(d0 + 0) * (VT_STRIDE / 2)] = (bf16)(vv.x & 0xffffu); vt[(d0 + 1) * (VT_STRIDE / 2)] = (bf16)(vv.x >> 16);
        vt[(d0 + 2) * (VT_STRIDE / 2)] = (bf16)(vv.y & 0xffffu); vt[(d0 + 3) * (VT_STRIDE / 2)] = (bf16)(vv.y >> 16);
        vt[(d0 + 4) * (VT_STRIDE / 2)] = (bf16)(vv.z & 0xffffu); vt[(d0 + 5) * (VT_STRIDE / 2)] = (bf16)(vv.z >> 16);
        vt[(d0 + 6) * (VT_STRIDE / 2)] = (bf16)(vv.w & 0xffffu); vt[(d0 + 7) * (VT_STRIDE / 2)] = (bf16)(vv.w >> 16);
    }
    __syncthreads();
    const int hq = kvh * 4 + (wave >> 1), th = wave & 1, r32 = lane & 31, h = lane >> 5;
    const int qrow = row0 + th * 32 + r32;
    bf16x8 qf[4];
#pragma unroll
    for (int s = 0; s < 4; ++s) qf[s] = *(const GAS bf16x8*)(Qb + (size_t)qrow * 512 + hq * 64 + 16 * s + 8 * h);
    f32x16 st[6];
    const float SC = 0.125f * 1.4426950408889634f;
    const float sink2 = a->sinks[hq] * 1.4426950408889634f;
    float mx = sink2;
#pragma unroll
    for (int kb = 0; kb < 6; ++kb) {
#pragma unroll
        for (int r = 0; r < 16; ++r) st[kb][r] = 0.f;
        if (kb >= kb_lo) {
#pragma unroll
            for (int s = 0; s < 4; ++s) {
                const bf16x8 kf = *(const LAS bf16x8*)(lds + LDS_KL + (kb * 32 + r32) * KL_STRIDE + (16 * s + 8 * h) * 2);
                st[kb] = MFMA32(kf, qf[s], st[kb]);
            }
#pragma unroll
            for (int r = 0; r < 16; ++r) { st[kb][r] *= SC; mx = fmaxf(mx, st[kb][r]); }
        }
    }
    mx = fmaxf(mx, __shfl_xor(mx, 32));
    float sum = 0.f;
#pragma unroll
    for (int kb = 0; kb < 6; ++kb) {
        if (kb >= kb_lo) {
#pragma unroll
            for (int r = 0; r < 16; ++r) { const float e = __builtin_amdgcn_exp2f(st[kb][r] - mx); st[kb][r] = e; sum += e; }
        }
    }
    sum += __shfl_xor(sum, 32);
    const float inv = 1.0f / (sum + __builtin_amdgcn_exp2f(sink2 - mx));
    f32x16 o[2];
#pragma unroll
    for (int db = 0; db < 2; ++db)
#pragma unroll
        for (int r = 0; r < 16; ++r) o[db][r] = 0.f;
#pragma unroll
    for (int kb = 0; kb < 6; ++kb) {
        if (kb >= kb_lo) {
#pragma unroll
            for (int s = 0; s < 2; ++s) {
                const bf16x8 pf = pack_regs8(st[kb], s);
#pragma unroll
                for (int db = 0; db < 2; ++db) {
                    const bf16x8 vf = *(const LAS bf16x8*)(lds + LDS_VT + (db * 32 + r32) * VT_STRIDE + (kb * 32 + 16 * s + 8 * h) * 2);
                    o[db] = MFMA32(vf, pf, o[db]);
                }
            }
        }
    }
#pragma unroll
    for (int db = 0; db < 2; ++db)
#pragma unroll
        for (int g4 = 0; g4 < 4; ++g4) {
            const size_t off = (size_t)qrow * 512 + hq * 64 + db * 32 + 8 * g4 + 4 * h;
            const v2u z = *(const GAS v2u*)(ZA + off);
            v2u w; w.x = pk2(o[db][4 * g4 + 0] * inv * bf_lo(z.x), o[db][4 * g4 + 1] * inv * bf_hi(z.x)); w.y = pk2(o[db][4 * g4 + 2] * inv * bf_lo(z.y), o[db][4 * g4 + 3] * inv * bf_hi(z.y));
            *(GAS v2u*)(A1 + off) = w;
        }
    __syncthreads();
}

struct SsmTab { int unused; };
template <bool FULL>
__device__ __forceinline__ void ssm_tab_load(SsmTab& T, AP, int, int) { T.unused = 0; }
__device__ __forceinline__ float lane_swap32(float x) {
    const unsigned u = __float_as_uint(x);
    const auto r = __builtin_amdgcn_permlane32_swap(u, u, false, false);
    return __uint_as_float((__builtin_amdgcn_mbcnt_hi(~0u, __builtin_amdgcn_mbcnt_lo(~0u, 0u)) & 32u) ? r[0] : r[1]);
}
template <bool FULL>
__device__ __forceinline__ void ssm_chunk(const SsmTab& T, AP a, LAS unsigned char* lds, int cr, int g, int wave, int lane, float (&cyr)[2], float (&cyi)[2]) {
    asm volatile("" : "+v"(lane));
    unsigned char* ws = a->ws;
    const bf16* U = (const bf16*)(ws + WS_U); const bf16* Bb = (const bf16*)(ws + WS_SSMB); const bf16* Cm = (const bf16*)(ws + WS_SSMC);
    const int p32 = lane & 31, h = lane >> 5, row0 = cr * 64;
    LAS unsigned char* Hl = lds + LDS_HL + wave * HL_WAVE;
    const int t16 = lane & 15, q4 = lane >> 4, ch = g * 16 + 4 * q4;
    bf16x8 ufs[2], bb[4], cmf[4]; v2u uus[2][2]; f32x4 apv[2][3]; f32x4 dsk = {0.f, 0.f, 0.f, 0.f};
    const float* apow = (const float*)(ws + WS_APOW);
#pragma unroll
    for (int pi = 0; pi < 2; ++pi) {
        const GAS f32x4* ap = (const GAS f32x4*)(apow + (size_t)(g * 64 + pi * 32 + p32) * 12);
        apv[pi][0] = ap[0]; apv[pi][1] = ap[1]; apv[pi][2] = ap[2];
    }
#pragma unroll
    for (int nb = 0; nb < 4; ++nb) bb[nb] = *(const GAS bf16x8*)(Bb + (size_t)(g * 128 + nb * 32 + p32) * 16 + 8 * h);
#pragma unroll
    for (int tb = 0; tb < 2; ++tb) ufs[tb] = *(const GAS bf16x8*)(U + (size_t)(row0 + tb * 32 + p32) * 512 + g * 16 + 8 * h);
    if (FULL) {
#pragma unroll
        for (int ks = 0; ks < 4; ++ks) cmf[ks] = *(const GAS bf16x8*)(Cm + (size_t)(g * 16 + t16) * 128 + 32 * ks + 8 * q4);
        dsk = *(const GAS f32x4*)(a->ssm_d + ch);
#pragma unroll
        for (int tb = 0; tb < 2; ++tb)
#pragma unroll
            for (int mt = 0; mt < 2; ++mt) uus[tb][mt] = *(const GAS v2u*)(U + (size_t)(row0 + tb * 32 + 16 * mt + t16) * 512 + ch);
    }
    __builtin_amdgcn_sched_barrier(0);
    float A1r[2], A1i[2], A2r[2], A2i[2], A3r[2], A3i[2], A4r[2], A4i[2], A8r[2], A8i[2];
#pragma unroll
    for (int pi = 0; pi < 2; ++pi) {
        const f32x4 q0 = apv[pi][0], q1 = apv[pi][1], q2 = apv[pi][2];
        A1r[pi] = q0[0]; A1i[pi] = q0[1]; A2r[pi] = q0[2]; A2i[pi] = q0[3]; A3r[pi] = q1[0]; A3i[pi] = q1[1]; A4r[pi] = q1[2]; A4i[pi] = q1[3]; A8r[pi] = q2[0]; A8i[pi] = q2[1];
    }
#pragma unroll
    for (int tb = 0; tb < 2; ++tb) {
        const bf16x8 uf = ufs[tb];
        f32x16 x[4];
#pragma unroll
        for (int nb = 0; nb < 4; ++nb) {
#pragma unroll
            for (int r = 0; r < 16; ++r) x[nb][r] = 0.f;
            x[nb] = MFMA32(uf, bb[nb], x[nb]);
        }
#pragma unroll
        for (int pi = 0; pi < 2; ++pi) {
            f32x16& xr = x[pi]; f32x16& xi = x[2 + pi];
            const float a1r = A1r[pi], a1i = A1i[pi], a4r = A4r[pi], a4i = A4i[pi], a8r = A8r[pi], a8i = A8i[pi];
#pragma unroll
            for (int j = 0; j < 4; ++j) {
#pragma unroll
                for (int i = 1; i < 4; ++i) {
                    const float pr = xr[4 * j + i - 1], pim = xi[4 * j + i - 1];
                    xr[4 * j + i] += a1r * pr - a1i * pim;
                    xi[4 * j + i] += a1r * pim + a1i * pr;
                }
            }
            float Cr = cyr[pi], Ci = cyi[pi];
            float car[4], cai[4];
#pragma unroll
            for (int j = 0; j < 4; ++j) {
                const float er = xr[4 * j + 3], ei = xi[4 * j + 3];
                const float per = lane_swap32(er), pei = lane_swap32(ei);
                const float evr = h == 0 ? er : per, evi = h == 0 ? ei : pei;
                const float odr = h == 0 ? per : er, odi = h == 0 ? pei : ei;
                const float t4r = a4r * Cr - a4i * Ci + evr, t4i = a4r * Ci + a4i * Cr + evi;
                car[j] = h == 0 ? Cr : t4r; cai[j] = h == 0 ? Ci : t4i;
                const float Er = a4r * evr - a4i * evi + odr, Ei = a4r * evi + a4i * evr + odi;
                const float nr = a8r * Cr - a8i * Ci + Er, ni = a8r * Ci + a8i * Cr + Ei;
                Cr = nr; Ci = ni;
            }
            cyr[pi] = Cr; cyi[pi] = Ci;
            if (FULL) {
                const float pw_r[4] = {a1r, A2r[pi], A3r[pi], a4r}, pw_i[4] = {a1i, A2i[pi], A3i[pi], a4i};
#pragma unroll
                for (int j = 0; j < 4; ++j)
#pragma unroll
                    for (int i = 0; i < 4; ++i) {
                        const float hr = xr[4 * j + i] + pw_r[i] * car[j] - pw_i[i] * cai[j];
                        const float hi = xi[4 * j + i] + pw_r[i] * cai[j] + pw_i[i] * car[j];
                        const int trow = i + 8 * j + 4 * h;
                        *(LAS unsigned*)(Hl + trow * HL_STRIDE + p32 * 8 + pi * 4) = cvtpk_s(hr, hi);
                    }
            }
        }
        if (FULL) {
            bf16* Zg = (bf16*)(ws + WS_Z);
#pragma unroll
            for (int mt = 0; mt < 2; ++mt) {
                f32x4 ya = {0.f, 0.f, 0.f, 0.f};
#pragma unroll
                for (int ks = 0; ks < 4; ++ks) {
                    const bf16x8 hb = *(const LAS bf16x8*)(Hl + (16 * mt + t16) * HL_STRIDE + (32 * ks + 8 * q4) * 2);
                    ya = MFMA16(cmf[ks], hb, ya);
                }
                const int t = tb * 32 + 16 * mt + t16;
                const v2u uu = uus[tb][mt];
                const float z0 = gelu_tanh_f(ya[0] + dsk[0] * bf_lo(uu.x)), z1 = gelu_tanh_f(ya[1] + dsk[1] * bf_hi(uu.x));
                const float z2 = gelu_tanh_f(ya[2] + dsk[2] * bf_lo(uu.y)), z3 = gelu_tanh_f(ya[3] + dsk[3] * bf_hi(uu.y));
                v2u w; w.x = pk2(z0, z1); w.y = pk2(z2, z3);
                *(GAS v2u*)(Zg + (size_t)(row0 + t) * 512 + ch) = w;
            }
        }
    }
}

__device__ __forceinline__ void ssm_local_pass(AP a, LAS unsigned char* lds, int wave, int lane) {
    asm volatile("" : "+v"(lane));
    const int p32 = lane & 31, h = lane >> 5;
    for (int bg = blockIdx.x; bg < 256; bg += gridDim.x) {
        const int b = bg >> 5, g = bg & 31;
        SsmTab T; ssm_tab_load<false>(T, a, g, lane);
        float cr_[2] = {0.f, 0.f}, ci_[2] = {0.f, 0.f};
#pragma unroll 1
        for (int q = 0; q < 4; ++q) ssm_chunk<false>(T, a, lds, b * 32 + 4 * wave + q, g, wave, lane, cr_, ci_);
        if (h == 0) {
            float* S = (float*)(a->ws + WS_SLOC) + (size_t)((b * 8 + wave) * 32 + g) * 128;
#pragma unroll
            for (int pi = 0; pi < 2; ++pi) { S[pi * 32 + p32] = cr_[pi]; S[64 + pi * 32 + p32] = ci_[pi]; }
        }
    }
}
__device__ __forceinline__ void ssm_full_pass(AP a, LAS unsigned char* lds, int wave, int lane) {
    asm volatile("" : "+v"(lane));
    unsigned char* ws = a->ws;
    const int p32 = lane & 31, h = lane >> 5;
    for (int bg = blockIdx.x; bg < 256; bg += gridDim.x) {
        const int b = bg >> 5, g = bg & 31;
        SsmTab T; ssm_tab_load<true>(T, a, g, lane);
        float hr[2] = {0.f, 0.f}, hi[2] = {0.f, 0.f};
        if (wave > 0) {
            const float* S0 = (const float*)(ws + WS_SLOC) + (size_t)((b * 8) * 32 + g) * 128 + p32;
            const float* a256 = (const float*)(ws + WS_APOW256);
            float ar[2], ai[2], sr[7][2], si[7][2];
#pragma unroll
            for (int pi = 0; pi < 2; ++pi) { ar[pi] = a256[(size_t)(g * 64 + pi * 32 + p32) * 2]; ai[pi] = a256[(size_t)(g * 64 + pi * 32 + p32) * 2 + 1]; }
#pragma unroll
            for (int j = 0; j < 7; ++j) {
                const int jc = j < wave ? j : wave - 1;
#pragma unroll
                for (int pi = 0; pi < 2; ++pi) { sr[j][pi] = S0[(size_t)jc * 4096 + pi * 32]; si[j][pi] = S0[(size_t)jc * 4096 + 64 + pi * 32]; }
            }
#pragma unroll
            for (int j = 0; j < 7; ++j) {
                if (j < wave) {
#pragma unroll
                    for (int pi = 0; pi < 2; ++pi) { const float nr = ar[pi] * hr[pi] - ai[pi] * hi[pi] + sr[j][pi], ni = ar[pi] * hi[pi] + ai[pi] * hr[pi] + si[j][pi]; hr[pi] = nr; hi[pi] = ni; }
                }
            }
        }
        const int nq = wave == 0 ? 5 : 4;
#pragma unroll 1
        for (int q = 0; q < nq; ++q) {
            int cr = b * 32 + 4 * wave + q;
            if (q == 4) {
                cr = 256 + b;
#pragma unroll
                for (int pi = 0; pi < 2; ++pi) { hr[pi] = a->st_re[(size_t)bg * 64 + pi * 32 + p32]; hi[pi] = a->st_im[(size_t)bg * 64 + pi * 32 + p32]; }
            }
            ssm_chunk<true>(T, a, lds, cr, g, wave, lane, hr, hi);
            if (h == 0 && ((q == 3 && wave == 7) || q == 4)) {
                float* sr = a->out + (q == 4 ? OFF_SRS : OFF_SRP) + (size_t)bg * 64; float* si = a->out + (q == 4 ? OFF_SIS : OFF_SIP) + (size_t)bg * 64;
#pragma unroll
                for (int pi = 0; pi < 2; ++pi) { sr[pi * 32 + p32] = hr[pi]; si[pi * 32 + p32] = hi[pi]; }
            }
        }
    }
}

constexpr int MPT_STRIDE = 272, MPT_WAVE = 32 * MPT_STRIDE;
template <int KS>
__device__ __forceinline__ void mini_acc(f32x4 (&acc)[2][4], const bf16* A, int lda, const bf16* Bt, int ldb, int kbeg, int lane) {
    const int l16 = lane & 15, q4 = lane >> 4;
    bf16x8 af[KS][2], bfr[KS][4];
#pragma unroll
    for (int ks = 0; ks < KS; ++ks) {
        const int k = kbeg + 32 * ks + 8 * q4;
#pragma unroll
        for (int mt = 0; mt < 2; ++mt) af[ks][mt] = *(const GAS bf16x8*)(A + (size_t)(16 * mt + l16) * lda + k);
#pragma unroll
        for (int nt = 0; nt < 4; ++nt) bfr[ks][nt] = *(const GAS bf16x8*)(Bt + (size_t)(16 * nt + l16) * ldb + k);
    }
#pragma unroll
    for (int ks = 0; ks < KS; ++ks)
#pragma unroll
        for (int mt = 0; mt < 2; ++mt)
#pragma unroll
            for (int nt = 0; nt < 4; ++nt) acc[mt][nt] = MFMA16(bfr[ks][nt], af[ks][mt], acc[mt][nt]);
}
__device__ __forceinline__ f32x4 mini_reduce(LAS unsigned char* lds, const f32x4 (&acc)[2][4], int tid, int wave, int lane) {
    const int l16 = lane & 15, q4 = lane >> 4;
#pragma unroll
    for (int mt = 0; mt < 2; ++mt)
#pragma unroll
        for (int nt = 0; nt < 4; ++nt) *(LAS f32x4*)(lds + wave * MPT_WAVE + (16 * mt + l16) * MPT_STRIDE + (16 * nt + 4 * q4) * 4) = acc[mt][nt];
    __syncthreads();
    const int t = tid >> 4, n4 = (tid & 15) * 4;
    f32x4 s = {0.f, 0.f, 0.f, 0.f};
#pragma unroll
    for (int w = 0; w < NWAVES; ++w) s += *(const LAS f32x4*)(lds + w * MPT_WAVE + t * MPT_STRIDE + n4 * 4);
    __syncthreads();
    return s;
}
#define MINI_ZERO(acc) _Pragma("unroll") for (int _m = 0; _m < 2; ++_m) _Pragma("unroll") for (int _n = 0; _n < 4; ++_n) acc[_m][_n] = (f32x4){0.f, 0.f, 0.f, 0.f}
__device__ __forceinline__ void mini_merge(AP a, LAS unsigned char* lds, int item, int tid, int wave, int lane) {
    asm volatile("" : "+v"(tid), "+v"(lane));
    unsigned char* ws = a->ws;
    const int rb = item >> 4, cb = item & 15, r0 = MP + 32 * rb, n0 = 64 * cb;
    const bf16* AST = (const bf16*)(ws + WS_AST); const bf16* WST = (const bf16*)(ws + WS_WST);
    f32x4 ya[2][4], ys[2][4]; MINI_ZERO(ya); MINI_ZERO(ys);
    mini_acc<2>(ya, AST + (size_t)r0 * 512, 512, WST + (size_t)n0 * 512, 512, wave * 64, lane);
    mini_acc<2>(ys, AST + (size_t)(M + r0) * 512, 512, WST + (size_t)(1024 + n0) * 512, 512, wave * 64, lane);
    const bf16* GA = (const bf16*)(ws + WS_GA); const bf16* GS = (const bf16*)(ws + WS_GS);
    const int l16 = lane & 15, q4 = lane >> 4;
#pragma unroll
    for (int mt = 0; mt < 2; ++mt)
#pragma unroll
        for (int nt = 0; nt < 4; ++nt) {
            const size_t o = (size_t)(r0 + 16 * mt + l16) * DM + n0 + 16 * nt + 4 * q4;
            const v2u ga = *(const GAS v2u*)(GA + o), gs = *(const GAS v2u*)(GS + o);
            ya[mt][nt][0] = ya[mt][nt][0] * bf_lo(ga.x) + ys[mt][nt][0] * bf_lo(gs.x); ya[mt][nt][1] = ya[mt][nt][1] * bf_hi(ga.x) + ys[mt][nt][1] * bf_hi(gs.x);
            ya[mt][nt][2] = ya[mt][nt][2] * bf_lo(ga.y) + ys[mt][nt][2] * bf_lo(gs.y); ya[mt][nt][3] = ya[mt][nt][3] * bf_hi(ga.y) + ys[mt][nt][3] * bf_hi(gs.y);
        }
    const f32x4 v = mini_reduce(lds, ya, tid, wave, lane);
    const int t = tid >> 4, n4 = (tid & 15) * 4;
    v2u w; w.x = pk2(v[0], v[1]); w.y = pk2(v[2], v[3]);
    *(GAS v2u*)((bf16*)(ws + WS_XN) + (size_t)(r0 + t) * DM + n0 + n4) = w;
}
__device__ __forceinline__ void mini_h1_pp(AP a, LAS unsigned char* lds, int item, int tid, int wave, int lane) {
    asm volatile("" : "+v"(tid), "+v"(lane));
    unsigned char* ws = a->ws;
    const int rb = item >> 4, cb = item & 15, r0 = MP + 32 * rb, n0 = 64 * cb;
    const int t = tid >> 4, n4 = (tid & 15) * 4;
    {
        f32x4 acc[2][4]; MINI_ZERO(acc);
        mini_acc<4>(acc, (const bf16*)(ws + WS_XN) + (size_t)r0 * DM, DM, (const bf16*)(ws + WS_WOUT) + (size_t)n0 * DM, DM, wave * 128, lane);
        const f32x4 v = mini_reduce(lds, acc, tid, wave, lane);
        const size_t o = (size_t)(r0 + t) * DM + n0 + n4;
        const f32x4 h = *(const GAS f32x4*)(a->x_sample + (o - (size_t)MP * DM)) + v;
        *(GAS f32x4*)(a->out + o) = h;
        v2u w; w.x = pk2(h[0], h[1]); w.y = pk2(h[2], h[3]);
        *(GAS v2u*)((bf16*)(ws + WS_GA) + o) = w;
    }
    {
        f32x4 acc[2][4]; MINI_ZERO(acc);
        mini_acc<1>(acc, (const bf16*)(ws + WS_P) + (size_t)r0 * PLE, PLE, (const bf16*)(ws + WS_WPP) + (size_t)n0 * PLE, PLE, wave * 32, lane);
        const f32x4 v = mini_reduce(lds, acc, tid, wave, lane);
        v2u w; w.x = pk2(v[0], v[1]); w.y = pk2(v[2], v[3]);
        *(GAS v2u*)((bf16*)(ws + WS_GS) + (size_t)(r0 + t) * DM + n0 + n4) = w;
    }
}
__device__ __forceinline__ void mini_h2(AP a, LAS unsigned char* lds, int item, int tid, int wave, int lane) {
    asm volatile("" : "+v"(tid), "+v"(lane));
    unsigned char* ws = a->ws;
    const int rb = item >> 4, cb = item & 15, r0 = MP + 32 * rb, n0 = 64 * cb;
    const int t = tid >> 4, n4 = (tid & 15) * 4;
    f32x4 acc[2][4]; MINI_ZERO(acc);
    mini_acc<4>(acc, (const bf16*)(ws + WS_GA) + (size_t)r0 * DM, DM, (const bf16*)(ws + WS_WPG) + (size_t)n0 * DM, DM, wave * 128, lane);
    const f32x4 v = mini_reduce(lds, acc, tid, wave, lane);
    const size_t o = (size_t)(r0 + t) * DM + n0 + n4;
    const v2u pp = *(const GAS v2u*)((const bf16*)(ws + WS_GS) + o);
    f32x4 h = *(const GAS f32x4*)(a->out + o);
    h[0] += sigmoid_f(v[0]) * bf_lo(pp.x); h[1] += sigmoid_f(v[1]) * bf_hi(pp.x); h[2] += sigmoid_f(v[2]) * bf_lo(pp.y); h[3] += sigmoid_f(v[3]) * bf_hi(pp.y);
    *(GAS f32x4*)(a->out + o) = h;
    float sq = (h[0] * h[0] + h[1] * h[1]) + (h[2] * h[2] + h[3] * h[3]);
    sq += __shfl_xor(sq, 1); sq += __shfl_xor(sq, 2); sq += __shfl_xor(sq, 4); sq += __shfl_xor(sq, 8);
    if ((tid & 15) == 0) ((float*)(ws + WS_SSQ))[(size_t)(r0 + t) * 16 + cb] = sq;
}

__device__ __forceinline__ void final_norm_row(AP a, int m, int lane) {
    GAS f32x4* yr = (GAS f32x4*)(a->out + (size_t)m * DM) + lane; const GAS f32x4* gr = (const GAS f32x4*)a->fgain + lane;
    const float* sq = (const float*)(a->ws + WS_SSQ) + (size_t)m * 16;
    const f32x4 s0 = *(const GAS f32x4*)sq, s1 = *(const GAS f32x4*)(sq + 4), s2 = *(const GAS f32x4*)(sq + 8), s3 = *(const GAS f32x4*)(sq + 12);
    const float ss = ((s0[0] + s0[1]) + (s0[2] + s0[3])) + ((s1[0] + s1[1]) + (s1[2] + s1[3])) + ((s2[0] + s2[1]) + (s2[2] + s2[3])) + ((s3[0] + s3[1]) + (s3[2] + s3[3]));
    const float r = 1.f / sqrtf(ss * (1.f / DM) + EPS);
#pragma unroll
    for (int j = 0; j < 4; ++j) { const f32x4 v = yr[64 * j], g = gr[64 * j]; yr[64 * j] = v * r * g; }
}

__global__ void __launch_bounds__(NWAVES * 64, 2) mega_fwd(Args args) {
    extern __shared__ __attribute__((aligned(16))) unsigned char lds_raw[];
    LAS unsigned char* lds = (LAS unsigned char*)lds_raw;
    volatile LAS unsigned* MISC = (volatile LAS unsigned*)(lds + MISC_OFF);
    const int tid = threadIdx.x, lane = tid & 63, wave = __builtin_amdgcn_readfirstlane(tid >> 6);
    const int G = gridDim.x, bx = blockIdx.x;
    gu32* ctl; { AP ap = args_ptr(); ctl = (gu32*)(ap->ws + WS_CTL); }
    for (int u = tid; u < (LDS_BYTES - MISC_OFF) / 4; u += NWAVES * 64) ((LAS unsigned*)(lds + MISC_OFF))[u] = 0u;
    __syncthreads();
    XcdBarrier bar; bar.bar = (unsigned*)(ctl + CW_BAR); bar.x = 0; bar.st = nullptr;
    if (N_LAUNCHES == 1) bar = xcd_barrier_post((unsigned*)(ctl + CW_BAR), MISC + 8);
#define GRID_BAR() do { if (N_LAUNCHES == 1) xcd_barrier(bar); } while (0)
    int lo, hi; { AP ap = args_ptr(); lo = ap->ph_lo; hi = ap->ph_hi; }
#define POS(k) ((k) <= 3 ? (k) : (k) == 8 ? 4 : (k) + 1)
#define IN(k) (lo <= POS(k) && POS(k) < hi)
#define BOTH(k) (IN(k) && lo <= POS(k) + 1 && POS(k) + 1 < hi)
#define REPS(k) 1

    if (IN(0)) { for (int rep = 0; rep < REPS(0); ++rep) { p0_prologue(args_ptr(), lds, wave, lane); if (BOTH(0) || rep + 1 < REPS(0)) GRID_BAR(); } }

    if (IN(1)) { for (int rep = 0; rep < REPS(1); ++rep) {
        AP ap = args_ptr(); unsigned char* ws = ap->ws;
        pg8::Gemm g{(const pg8::bf16_t*)(ws + WS_XN), (const pg8::bf16_t*)(ws + WS_WIN), M, INW, DM};
        pg8::StaticOrder S; S.init(M, INW, G, bx);
        pg8::EpiIn E{ws, ap->out};
        pg8::gemm_phase<pg8::EpiIn, pg8::StaticOrder, true, true>(lds, g, S, E);
        if (BOTH(1) || rep + 1 < REPS(1)) GRID_BAR();
    } }

    if (IN(2)) { for (int rep = 0; rep < REPS(2); ++rep) {
        AP ap = args_ptr();
        for (int u = bx; u < 528; u += G) attn_unit(ap, lds, u, tid, wave, lane);
        ssm_local_pass(ap, lds, wave, lane);
        if (BOTH(2) || rep + 1 < REPS(2)) GRID_BAR();
    } }

    if (IN(3)) {
        AP ap = args_ptr();
        ssm_full_pass(ap, lds, wave, lane);
        if (BOTH(3)) GRID_BAR();
    }

    if (IN(8)) {
        AP ap = args_ptr(); unsigned char* ws = ap->ws;
        pg8::Gemm g{(const pg8::bf16_t*)(ws + WS_Z), (const pg8::bf16_t*)(ws + WS_WGLU), M, 512, 512};
        pg8::StaticOrder S; S.init(M, 512, G, bx);
        pg8::EpiGLU E{ws};
        pg8::gemm_phase<pg8::EpiGLU, pg8::StaticOrder, true, true>(lds, g, S, E);
        if (BOTH(8)) GRID_BAR();
    }

    if (IN(4)) { for (int rep = 0; rep < REPS(4); ++rep) {
        AP ap = args_ptr(); unsigned char* ws = ap->ws;
        pg8::Gemm g{(const pg8::bf16_t*)(ws + WS_AST), (const pg8::bf16_t*)(ws + WS_WST), 2 * M, 2048, 512};
        pg8::PairOrder S; S.base.init(MP, DM, G, bx); S.dM = M / 256; S.dN = 4;
        pg8::EpiMerge E{ws};
        pg8::gemm_phase<pg8::EpiMerge, pg8::PairOrder, true, true>(lds, g, S, E);
        for (int it = bx; it < 256; it += G) mini_merge(ap, lds, it, tid, wave, lane);
        if (BOTH(4) || rep + 1 < REPS(4)) GRID_BAR();
    } }

    if (IN(5)) { for (int rep = 0; rep < REPS(5); ++rep) {
        AP ap = args_ptr(); unsigned char* ws = ap->ws;
        pg8::Gemm g{(const pg8::bf16_t*)(ws + WS_XN), (const pg8::bf16_t*)(ws + WS_WOUT), MP, DM, DM};
        pg8::StaticOrder S; S.init(MP, DM, G, bx);
        pg8::EpiH1 E{ap->x_prompt, ap->x_sample, ap->out, ws};
        pg8::gemm_phase<pg8::EpiH1, pg8::StaticOrder, true, true>(lds, g, S, E);
        for (int it = bx; it < 256; it += G) mini_h1_pp(ap, lds, it, tid, wave, lane);
        if (BOTH(5) || rep + 1 < REPS(5)) GRID_BAR();
    } }

    if (IN(6)) {
        AP ap = args_ptr(); unsigned char* ws = ap->ws;
        {
            pg8::Gemm g{(const pg8::bf16_t*)(ws + WS_P), (const pg8::bf16_t*)(ws + WS_WPP), MP, DM, PLE};
            pg8::StaticOrder S; S.init(MP, DM, G, bx);
            pg8::EpiPP E{ws};
            pg8::gemm_phase<pg8::EpiPP, pg8::StaticOrder, true, true>(lds, g, S, E);
        }
        {
            pg8::Gemm g{(const pg8::bf16_t*)(ws + WS_GA), (const pg8::bf16_t*)(ws + WS_WPG), MP, DM, DM};
            pg8::StaticOrder S; S.init(MP, DM, G, bx);
            pg8::EpiH2 E{ap->out, ws};
            pg8::gemm_phase<pg8::EpiH2, pg8::StaticOrder, true, true>(lds, g, S, E);
        }
        for (int it = bx; it < 256; it += G) mini_h2(ap, lds, it, tid, wave, lane);
        if (BOTH(6)) GRID_BAR();
    }

    if (IN(7)) {
        const int gw = bx * NWAVES + wave, NGW = G * NWAVES;
        AP ap = args_ptr();
        for (int m = gw; m < M; m += NGW) final_norm_row(ap, m, lane);
    }
#undef IN
#undef BOTH
}

#ifndef PROBE_EXTRA
#define PROBE_EXTRA -1
#endif
extern "C" void kernel_launch(void* const* d_in, const int* in_sizes, int n_in, void* d_out, int out_size, void* d_ws, size_t ws_size, hipStream_t stream) {
    static int grid = 0;
    if (grid == 0) {
        if (n_in != 26 || (size_t)out_size != OUT_TOTAL || ws_size < WS_END) { fprintf(stderr, "kernel_launch: unexpected shapes (n_in %d, out %d, ws %zu); nothing launched\n", n_in, out_size, ws_size); grid = -1; return; }
        int dev = 0, cus = 0, per_cu = 0;
        if (hipGetDevice(&dev) != hipSuccess || hipDeviceGetAttribute(&cus, hipDeviceAttributeMultiprocessorCount, dev) != hipSuccess) { grid = -1; return; }
        if (hipFuncSetAttribute((const void*)mega_fwd, hipFuncAttributeMaxDynamicSharedMemorySize, LDS_BYTES) != hipSuccess) { fprintf(stderr, "kernel_launch: hipFuncSetAttribute failed\n"); grid = -1; return; }
        if (hipOccupancyMaxActiveBlocksPerMultiprocessor(&per_cu, (const void*)mega_fwd, NWAVES * 64, LDS_BYTES) != hipSuccess || per_cu < 1) { fprintf(stderr, "kernel_launch: occupancy query says %d blocks per CU\n", per_cu); per_cu = 1; }
        (void)hipGetLastError();
        grid = cus;
    }
    if (grid < 0) return;
    if (hipMemsetAsync((char*)d_ws + WS_CTL, 0, CTL_ZERO_BYTES, stream) != hipSuccess) { fprintf(stderr, "kernel_launch: memset failed\n"); return; }
    Args a{};
    const float** pa = (const float**)&a;
    for (int i = 0; i < 26; ++i) pa[i] = (const float*)d_in[i];
    a.out = (float*)d_out; a.ws = (unsigned char*)d_ws;
    for (int li = 0; li < N_LAUNCHES; ++li) {
        a.ph_lo = (N_LAUNCHES == 1) ? 0 : li; a.ph_hi = (N_LAUNCHES == 1) ? N_PHASES : li + 1;
        for (int rep = 0; rep < ((N_LAUNCHES > 1 && li == PROBE_EXTRA) ? 2 : 1); ++rep) {
            hipLaunchKernelGGL(mega_fwd, dim3(grid), dim3(NWAVES * 64), LDS_BYTES, stream, a);
            const hipError_t le = hipPeekAtLastError();
            if (le != hipSuccess) { fprintf(stderr, "kernel_launch: launch %d failed: %s\n", li, hipGetErrorName(le)); break; }
        }
    }
}
```
